# Optimizing an MI355X kernel written in HIP

```python
import jax, jax.numpy as jnp
from jax import lax
import numpy as np

D_MODEL = 2048
BATCH = 4
SEQ = 2048
DEPTH = 4
DEC_BATCH = 8
DEC_SEQ = 32
PAST_LEN = 1024

CHUNK = 64
N_EVEN = (DEPTH + 1) // 2
N_ODD = DEPTH // 2
LRU_WIDTH = D_MODEL // 2
LRU_HEADS = 8
LRU_BLOCK = LRU_WIDTH // LRU_HEADS
CONV_WIDTH = 4
LRU_C = 8.0
MLA_HEADS = 8
QK_NOPE = 128
QK_ROPE = 64
V_DIM = 128
Q_LORA = 512
KV_LORA = 256
ROPE_THETA = 10000.0
Q_BLOCK = 128
IN_COLS = 2 * LRU_WIDTH + Q_LORA + KV_LORA + QK_ROPE
MIX_OUT = LRU_WIDTH + MLA_HEADS * V_DIM
POOL_WINDOWS = (2, 4, 8, 16)
POOL_GROUPS = 4
POOL_GW = D_MODEL // POOL_GROUPS
POOL_BUF = 15
N_MEM = 256
MEM_HEADS = 4
MEM_HEAD_DIM = D_MODEL // MEM_HEADS
D_FF = 4 * D_MODEL
DN_ALPHA = (2.0 * DEPTH) ** 0.25
DN_BETA = (8.0 * DEPTH) ** -0.25
LN_EPS = 1e-5
RMS_EPS = 1e-6

kernel_name = 'hybrid_stream_rglru_mla_pool_step'

F32 = jnp.float32


def layer_norm(x, g, b):
    xf = x.astype(F32)
    mu = jnp.mean(xf, -1, keepdims=True)
    var = jnp.mean(jnp.square(xf - mu), -1, keepdims=True)
    return ((xf - mu) * lax.rsqrt(var + LN_EPS) * g.astype(F32) + b.astype(F32)).astype(x.dtype)


def rms_norm(x, g):
    xf = x.astype(F32)
    return (xf * lax.rsqrt(jnp.mean(jnp.square(xf), -1, keepdims=True) + RMS_EPS) * g.astype(F32)).astype(x.dtype)


def rope(x, pos):
    half = QK_ROPE // 2
    inv = ROPE_THETA ** (-jnp.arange(half, dtype=F32) / half)
    ang = pos.astype(F32)[:, None] * inv[None, :]
    shape = (pos.shape[0],) + (1,) * (x.ndim - 3) + (half,)
    cos, sin = jnp.cos(ang).reshape(shape), jnp.sin(ang).reshape(shape)
    xf = x.astype(F32)
    x1, x2 = xf[..., :half], xf[..., half:]
    return jnp.concatenate([x1 * cos - x2 * sin, x1 * sin + x2 * cos], -1).astype(x.dtype)


def causal_conv(u, buf, w, b):
    full = jnp.concatenate([buf, u], axis=1)
    T = u.shape[1]
    y = b
    for k in range(CONV_WIDTH):
        y = y + w[k] * full[:, k:k + T]
    return y, full[:, full.shape[1] - (CONV_WIDTH - 1):]


def rg_lru(u, h0, ga_w, ga_b, gx_w, gx_b, lam):
    B, T, _ = u.shape
    ub = u.reshape(B, T, LRU_HEADS, LRU_BLOCK)
    r = jax.nn.sigmoid(jnp.einsum('bthi,hij->bthj', ub, ga_w) + ga_b).reshape(B, T, LRU_WIDTH)
    ig = jax.nn.sigmoid(jnp.einsum('bthi,hij->bthj', ub, gx_w) + gx_b).reshape(B, T, LRU_WIDTH)
    log_a = -LRU_C * r.astype(F32) * jax.nn.softplus(-lam.astype(F32))
    a = jnp.exp(log_a)
    bterm = jnp.sqrt(-jnp.expm1(2.0 * log_a)) * (ig * u).astype(F32)
    bterm = bterm.at[:, 0].add(a[:, 0] * h0.astype(F32))

    def combine(left, right):
        a1, b1 = left
        a2, b2 = right
        return a1 * a2, a2 * b1 + b2

    _, h = lax.associative_scan(combine, (a, bterm), axis=1)
    return h.astype(u.dtype), h[:, -1].astype(u.dtype)


def mla_attention(q_nope, q_pe, ckv, kpe, q_pos, w_uk, w_uv):
    B, Tq = q_nope.shape[:2]
    q_lat = jnp.einsum('bqhn,chn->bqhc', q_nope, w_uk)
    scale = (QK_NOPE + QK_ROPE) ** -0.5
    k_chunk = jnp.arange(ckv.shape[1]) // CHUNK

    def block(args):
        ql, qp, qpos = args
        s = jnp.einsum('bqhc,bkc->bhqk', ql, ckv) + jnp.einsum('bqhr,bkr->bhqk', qp, kpe)
        s = s.astype(F32) * scale
        mask = k_chunk[None, :] <= (qpos // CHUNK)[:, None]
        s = jnp.where(mask[None, None], s, -jnp.inf)
        p = jax.nn.softmax(s, axis=-1).astype(ckv.dtype)
        return jnp.einsum('bhqk,bkc->bqhc', p, ckv)

    if Tq > Q_BLOCK and Tq % Q_BLOCK == 0:
        nb = Tq // Q_BLOCK
        split = lambda t: jnp.moveaxis(t.reshape((B, nb, Q_BLOCK) + t.shape[2:]), 1, 0)
        o = lax.map(block, (split(q_lat), split(q_pe), q_pos.reshape(nb, Q_BLOCK)))
        o_lat = jnp.moveaxis(o, 0, 1).reshape(B, Tq, MLA_HEADS, KV_LORA)
    else:
        o_lat = block((q_lat, q_pe, q_pos))
    return jnp.einsum('bqhc,chv->bqhv', o_lat, w_uv).reshape(B, Tq, MLA_HEADS * V_DIM)


def rec_attn_mixer(x, pos, conv_buf, h0, ckv_past, kpe_past,
                   w_in, q_norm_g, w_uq, kv_norm_g, w_uk, w_uv,
                   conv_w, conv_b, ga_w, ga_b, gx_w, gx_b, lam, w_out):
    B, T, _ = x.shape
    z = x @ w_in
    o1 = LRU_WIDTH
    o2 = o1 + LRU_WIDTH
    o3 = o2 + Q_LORA
    o4 = o3 + KV_LORA
    u, gate, c_q, c_kv, k_pe = z[..., :o1], z[..., o1:o2], z[..., o2:o3], z[..., o3:o4], z[..., o4:]
    u_c, new_conv = causal_conv(u, conv_buf, conv_w, conv_b)
    h, h_last = rg_lru(u_c, h0, ga_w, ga_b, gx_w, gx_b, lam)
    rec_out = h * jax.nn.gelu(gate)
    q = (rms_norm(c_q, q_norm_g) @ w_uq).reshape(B, T, MLA_HEADS, QK_NOPE + QK_ROPE)
    q_nope, q_pe = q[..., :QK_NOPE], rope(q[..., QK_NOPE:], pos)
    ckv_new = rms_norm(c_kv, kv_norm_g)
    kpe_new = rope(k_pe, pos)
    ckv_all = jnp.concatenate([ckv_past, ckv_new], axis=1)
    kpe_all = jnp.concatenate([kpe_past, kpe_new], axis=1)
    attn_out = mla_attention(q_nope, q_pe, ckv_all, kpe_all, pos, w_uk, w_uv)
    out = jnp.concatenate([rec_out, attn_out], axis=-1) @ w_out
    return out, new_conv, h_last, ckv_new, kpe_new


def pool_mixer(x, pos, pool_buf, pool_w, pool_scale):
    B, T, D = x.shape
    full_x = jnp.concatenate([pool_buf, x], axis=1)
    full = full_x.astype(F32)
    cs = jnp.concatenate([jnp.zeros((B, 1, D), F32), jnp.cumsum(full, axis=1)], axis=1)
    end = cs[:, POOL_BUF + 1:]
    outs = []
    for g, w in enumerate(POOL_WINDOWS):
        sl = slice(g * POOL_GW, (g + 1) * POOL_GW)
        start = cs[:, POOL_BUF + 1 - w:POOL_BUF + 1 - w + T, sl]
        cnt = jnp.minimum(pos + 1, w).astype(F32)[None, :, None]
        outs.append((end[..., sl] - start) / cnt - full[:, POOL_BUF:, sl])
    d = jnp.stack(outs, axis=2).astype(x.dtype)
    y = jnp.einsum('btgi,gij->btgj', d, pool_w).reshape(B, T, D) * pool_scale
    return y, full_x[:, full_x.shape[1] - POOL_BUF:]


def cross_attention(x, mem_k, mem_v, wq, wo):
    B, T, _ = x.shape
    q = (x @ wq).reshape(B, T, MEM_HEADS, MEM_HEAD_DIM)
    k = mem_k.reshape(B, -1, MEM_HEADS, MEM_HEAD_DIM)
    v = mem_v.reshape(B, -1, MEM_HEADS, MEM_HEAD_DIM)
    s = jnp.einsum('bqhd,bkhd->bhqk', q, k).astype(F32) * (MEM_HEAD_DIM ** -0.5)
    p = jax.nn.softmax(s, axis=-1).astype(x.dtype)
    o = jnp.einsum('bhqk,bkhd->bqhd', p, v).reshape(B, T, D_MODEL)
    return o @ wo


def sq_relu_mlp(x, w_up, w_down):
    return jnp.square(jax.nn.relu(x @ w_up)) @ w_down


def trunk(x, t_past, mem_k, mem_v, conv_buf, h0, ckv_past, kpe_past, pool_buf, W):
    T = x.shape[1]
    pos = t_past + jnp.arange(T)
    convs, hs, ckvs, kpes, pools = [], [], [], [], []
    for l in range(DEPTH):
        j = l // 2
        if l % 2 == 0:
            mix, c, hh, ck, kp = rec_attn_mixer(
                x, pos, conv_buf[j], h0[j], ckv_past[j], kpe_past[j],
                W['w_in'][j], W['q_norm_g'][j], W['w_uq'][j], W['kv_norm_g'][j], W['w_uk'][j], W['w_uv'][j],
                W['conv_w'][j], W['conv_b'][j], W['gate_a_w'][j], W['gate_a_b'][j],
                W['gate_x_w'][j], W['gate_x_b'][j], W['lru_lambda'][j], W['w_out'][j])
            convs.append(c); hs.append(hh); ckvs.append(ck); kpes.append(kp)
        else:
            mix, pb = pool_mixer(x, pos, pool_buf[j], W['pool_w'][j], W['pool_scale'][j])
            pools.append(pb)
        x = layer_norm(DN_ALPHA * x + mix, W['ln_g'][l, 0], W['ln_b'][l, 0])
        x = layer_norm(DN_ALPHA * x + cross_attention(x, mem_k[l], mem_v[l], W['xa_wq'][l], W['xa_wo'][l]),
                       W['ln_g'][l, 1], W['ln_b'][l, 1])
        x = layer_norm(DN_ALPHA * x + sq_relu_mlp(x, W['mlp_up'][l], W['mlp_down'][l]),
                       W['ln_g'][l, 2], W['ln_b'][l, 2])
    return x, jnp.stack(convs), jnp.stack(hs), jnp.stack(ckvs), jnp.stack(kpes), jnp.stack(pools)


def setup_inputs(seed: int = 0) -> dict:
    key = jax.random.key(seed)
    ks = iter(jax.random.split(key, 40))
    nrm = lambda shape, scale: scale * jax.random.normal(next(ks), shape, F32)
    u = jax.random.uniform(next(ks), (N_EVEN, LRU_WIDTH), F32, 0.9, 0.999)
    s = u ** (1.0 / LRU_C)
    lru_lambda = jnp.log(s) - jnp.log1p(-s)
    return {
        'x_prompt': nrm((BATCH, SEQ, D_MODEL), 1.0),
        'x_sample': nrm((DEC_BATCH, DEC_SEQ, D_MODEL), 1.0),
        'mem_prompt': nrm((BATCH, N_MEM, D_MODEL), 1.0),
        'cache_mem_k': nrm((DEPTH, DEC_BATCH, N_MEM, D_MODEL), 1.0),
        'cache_mem_v': nrm((DEPTH, DEC_BATCH, N_MEM, D_MODEL), 1.0),
        'cache_mla_ckv': nrm((N_EVEN, DEC_BATCH, PAST_LEN, KV_LORA), 1.0),
        'cache_mla_kpe': nrm((N_EVEN, DEC_BATCH, PAST_LEN, QK_ROPE), 1.0),
        'state_rglru_h': nrm((N_EVEN, DEC_BATCH, LRU_WIDTH), 1.0),
        'state_rglru_conv': nrm((N_EVEN, DEC_BATCH, CONV_WIDTH - 1, LRU_WIDTH), 1.0),
        'state_pool': nrm((N_ODD, DEC_BATCH, POOL_BUF, D_MODEL), 1.0),
        'w_in': nrm((N_EVEN, D_MODEL, IN_COLS), D_MODEL ** -0.5),
        'q_norm_g': 1.0 + nrm((N_EVEN, Q_LORA), 0.02),
        'w_uq': nrm((N_EVEN, Q_LORA, MLA_HEADS * (QK_NOPE + QK_ROPE)), Q_LORA ** -0.5),
        'kv_norm_g': 1.0 + nrm((N_EVEN, KV_LORA), 0.02),
        'w_uk': nrm((N_EVEN, KV_LORA, MLA_HEADS, QK_NOPE), KV_LORA ** -0.5),
        'w_uv': nrm((N_EVEN, KV_LORA, MLA_HEADS, V_DIM), KV_LORA ** -0.5),
        'conv_w': nrm((N_EVEN, CONV_WIDTH, LRU_WIDTH), CONV_WIDTH ** -0.5),
        'conv_b': nrm((N_EVEN, LRU_WIDTH), 0.01),
        'gate_a_w': nrm((N_EVEN, LRU_HEADS, LRU_BLOCK, LRU_BLOCK), LRU_BLOCK ** -0.5),
        'gate_a_b': nrm((N_EVEN, LRU_HEADS, LRU_BLOCK), 0.01),
        'gate_x_w': nrm((N_EVEN, LRU_HEADS, LRU_BLOCK, LRU_BLOCK), LRU_BLOCK ** -0.5),
        'gate_x_b': nrm((N_EVEN, LRU_HEADS, LRU_BLOCK), 0.01),
        'lru_lambda': lru_lambda,
        'w_out': nrm((N_EVEN, MIX_OUT, D_MODEL), DN_BETA * MIX_OUT ** -0.5),
        'pool_w': nrm((N_ODD, POOL_GROUPS, POOL_GW, POOL_GW), DN_BETA * POOL_GW ** -0.5),
        'pool_scale': 1.0 + nrm((N_ODD, D_MODEL), 0.1),
        'xa_wq': nrm((DEPTH, D_MODEL, D_MODEL), D_MODEL ** -0.5),
        'xa_wk': nrm((DEPTH, D_MODEL, D_MODEL), D_MODEL ** -0.5),
        'xa_wv': nrm((DEPTH, D_MODEL, D_MODEL), D_MODEL ** -0.5),
        'xa_wo': nrm((DEPTH, D_MODEL, D_MODEL), DN_BETA * D_MODEL ** -0.5),
        'mlp_up': nrm((DEPTH, D_MODEL, D_FF), D_MODEL ** -0.5),
        'mlp_down': nrm((DEPTH, D_FF, D_MODEL), DN_BETA * D_FF ** -0.5),
        'ln_g': 1.0 + nrm((DEPTH, 3, D_MODEL), 0.02),
        'ln_b': nrm((DEPTH, 3, D_MODEL), 0.02),
    }


def reference(x_prompt, x_sample, mem_prompt, cache_mem_k, cache_mem_v, cache_mla_ckv, cache_mla_kpe,
              state_rglru_h, state_rglru_conv, state_pool,
              w_in, q_norm_g, w_uq, kv_norm_g, w_uk, w_uv, conv_w, conv_b,
              gate_a_w, gate_a_b, gate_x_w, gate_x_b, lru_lambda, w_out,
              pool_w, pool_scale, xa_wq, xa_wk, xa_wv, xa_wo, mlp_up, mlp_down, ln_g, ln_b):
    W = dict(w_in=w_in, q_norm_g=q_norm_g, w_uq=w_uq, kv_norm_g=kv_norm_g, w_uk=w_uk, w_uv=w_uv,
             conv_w=conv_w, conv_b=conv_b, gate_a_w=gate_a_w, gate_a_b=gate_a_b,
             gate_x_w=gate_x_w, gate_x_b=gate_x_b, lru_lambda=lru_lambda, w_out=w_out,
             pool_w=pool_w, pool_scale=pool_scale, xa_wq=xa_wq, xa_wo=xa_wo,
             mlp_up=mlp_up, mlp_down=mlp_down, ln_g=ln_g, ln_b=ln_b)
    bp = x_prompt.shape[0]
    dt = x_prompt.dtype
    p_mem_k = jnp.einsum('bmd,lde->lbme', mem_prompt, xa_wk)
    p_mem_v = jnp.einsum('bmd,lde->lbme', mem_prompt, xa_wv)
    y_prompt, p_conv, p_h, p_ckv, p_kpe, p_pool = trunk(
        x_prompt, 0, p_mem_k, p_mem_v,
        jnp.zeros((N_EVEN, bp, CONV_WIDTH - 1, LRU_WIDTH), dt),
        jnp.zeros((N_EVEN, bp, LRU_WIDTH), dt),
        jnp.zeros((N_EVEN, bp, 0, KV_LORA), dt),
        jnp.zeros((N_EVEN, bp, 0, QK_ROPE), dt),
        jnp.zeros((N_ODD, bp, POOL_BUF, D_MODEL), dt), W)
    y_sample, s_conv, s_h, s_ckv, s_kpe, s_pool = trunk(
        x_sample, cache_mla_ckv.shape[2], cache_mem_k, cache_mem_v,
        state_rglru_conv, state_rglru_h, cache_mla_ckv, cache_mla_kpe, state_pool, W)
    return (y_prompt, y_sample, p_conv, p_h, p_ckv, p_kpe, p_pool, p_mem_k, p_mem_v,
            s_conv, s_h, s_ckv, s_kpe, s_pool)
```

```cpp
#include <hip/hip_runtime.h>
#include <cstdio>
#include <cstdint>

#ifndef MK_LAUNCHES
#define MK_LAUNCHES 1
#endif

#define LAS __attribute__((address_space(3)))
#define DI __device__ __forceinline__
typedef unsigned short bf16_t;
typedef short bf16x8 __attribute__((ext_vector_type(8)));
typedef short s16x4 __attribute__((ext_vector_type(4)));
typedef float f32x4 __attribute__((ext_vector_type(4)));
typedef float f32x16 __attribute__((ext_vector_type(16)));
typedef unsigned u32x4 __attribute__((ext_vector_type(4)));
typedef unsigned u32x2 __attribute__((ext_vector_type(2)));
typedef __bf16 bf2_t __attribute__((ext_vector_type(2)));
typedef float f2_t __attribute__((ext_vector_type(2)));

DI int lane_id_asm() { int l; asm volatile("v_mbcnt_lo_u32_b32 %0, -1, 0\n\tv_mbcnt_hi_u32_b32 %0, -1, %0" : "=v"(l)); return l; }
DI unsigned pk2(float lo, float hi) { f2_t v = {lo, hi}; return __builtin_bit_cast(unsigned, __builtin_convertvector(v, bf2_t)); }
DI float bflo(unsigned w) { return __uint_as_float(w << 16); }
DI float bfhi(unsigned w) { return __uint_as_float(w & 0xffff0000u); }
DI float bf2f(bf16_t b) { return __uint_as_float(((unsigned)b) << 16); }

#define XB_TMO      128
#define XB_XCNT(j)  (256  + 64 * (j))
#define XB_XSUB(j)  (1280 + 64 * (j))
#define XB_XGEN(j)  (2304 + 64 * (j))
#define XB_TOP      3328
#define XB_TOPGEN   3392
#define XCD_BAR_WORDS 3456
#define XB_SPIN_CAP (1u << 18)

__device__ __forceinline__ unsigned xb_ld(unsigned* p)              { return __hip_atomic_load(p, __ATOMIC_RELAXED, __HIP_MEMORY_SCOPE_AGENT); }
__device__ __forceinline__ unsigned xb_add(unsigned* p, unsigned v) { return __hip_atomic_fetch_add(p, v, __ATOMIC_RELAXED, __HIP_MEMORY_SCOPE_AGENT); }
__device__ __forceinline__ unsigned xb_xcc_id() { return (unsigned)__builtin_amdgcn_s_getreg((3 << 11) | 20) & 0xFu; }
#define XB_SPIN(cond, bar) do { unsigned _sp = 0; while (cond) { __builtin_amdgcn_s_sleep(1); \
    if ((++_sp & 255u) == 0u) { if (xb_ld(&(bar)[XB_TMO])) break; if (_sp > XB_SPIN_CAP) { atomicAdd(&(bar)[XB_TMO], 1u); break; } } } } while (0)

struct XcdBarrier {
    unsigned* bar; unsigned x;
    volatile LAS unsigned* st;
};
__device__ __forceinline__ XcdBarrier xcd_barrier_post(unsigned* bar, volatile LAS unsigned* st) {
    XcdBarrier b; b.bar = bar; b.x = xb_xcc_id(); b.st = st;
    if (threadIdx.x == 0) (void)xb_add(&bar[XB_XCNT(b.x)], 1u);
    return b;
}
__device__ __forceinline__ void xcd_barrier_complete(unsigned* bar, unsigned x, unsigned& nloc, unsigned& nx) {
    const unsigned G = gridDim.x * gridDim.y * gridDim.z;
    unsigned sum, cnt, mine, sp = 0u;
    for (;;) {
        sum = 0u; cnt = 0u; mine = 0u;
#pragma unroll
        for (unsigned j = 0; j < 16; ++j) { const unsigned c = xb_ld(&bar[XB_XCNT(j)]); sum += c; cnt += (c > 0u) ? 1u : 0u; mine = (j == x) ? c : mine; }
        if (sum == G) break;
        __builtin_amdgcn_s_sleep(1);
        if ((++sp & 255u) == 0u) { if (xb_ld(&bar[XB_TMO])) break; if (sp > XB_SPIN_CAP) { atomicAdd(&bar[XB_TMO], 1u); break; } }
    }
    nloc = mine > 0u ? mine : 1u; nx = cnt > 0u ? cnt : 1u;
}
__device__ __forceinline__ void xcd_barrier(const XcdBarrier& b) {
    asm volatile("s_waitcnt vmcnt(0)" ::: "memory");
    __syncthreads();
    if (threadIdx.x == 0) {
        unsigned* bar = b.bar;
        __builtin_amdgcn_s_waitcnt(0);
        unsigned nloc = b.st[0], nx = b.st[1];
        if (nloc == 0u) { xcd_barrier_complete(bar, b.x, nloc, nx); b.st[0] = nloc; b.st[1] = nx; }
        const unsigned old = xb_add(&bar[XB_XSUB(b.x)], 1u);
        const unsigned gen = old / nloc;
        if (old + 1u == (gen + 1u) * nloc) {
            __builtin_amdgcn_fence(__ATOMIC_RELEASE, "agent");
            asm volatile("s_waitcnt vmcnt(0)" ::: "memory");
            const unsigned og = xb_add(&bar[XB_TOP], 1u);
            const unsigned tg = og / nx;
            if (og + 1u == (tg + 1u) * nx) xb_add(&bar[XB_TOPGEN], 1u);
            else XB_SPIN(xb_ld(&bar[XB_TOPGEN]) == tg, bar);
            __builtin_amdgcn_fence(__ATOMIC_ACQUIRE, "agent");
            xb_add(&bar[XB_XGEN(b.x)], 1u);
            asm volatile("s_waitcnt vmcnt(0)" ::: "memory");
        } else {
            XB_SPIN(xb_ld(&bar[XB_XGEN(b.x)]) == gen, bar);
            __builtin_amdgcn_fence(__ATOMIC_ACQUIRE, "agent");
            asm volatile("s_waitcnt vmcnt(0)" ::: "memory");
        }
    }
    __syncthreads();
}

constexpr int D = 2048, RP = 8192, RS = 256, R = RP + RS, RPAD = R + 256;
constexpr int INC = 2880, INP = 3072;
constexpr int KEYS = 16640, KEYSPAD = KEYS + 64;
constexpr int DFF = 8192;
constexpr float DN_ALPHA = 1.681792830507429f;
constexpr float LN_EPS = 1e-5f, RMS_EPS = 1e-6f;
constexpr int NPH = 2 + 14 * 4;
constexpr int LDS_BYTES = 147456;
constexpr int STAGE_OFF = 0, MISC_OFF = 131072;

constexpr size_t O_Y = 0;
constexpr size_t O_PCONV = 17301504, O_PH = 17326080, O_PCKV = 17334272, O_PKPE = 21528576, O_PPOOL = 22577152;
constexpr size_t O_PMEMK = 22822912, O_PMEMV = 31211520, O_SCONV = 39600128, O_SH = 39649280, O_SCKV = 39665664, O_SKPE = 39796736, O_SPOOL = 39829504;
constexpr size_t O_END = 40321024;

constexpr size_t al(size_t x) { return (x + 255) & ~(size_t)255; }
constexpr size_t WS_CTL = 0;
constexpr size_t CTL_BYTES = 65536;
constexpr size_t WS_ROPE = WS_CTL + CTL_BYTES;
constexpr size_t WS_WIN = WS_ROPE + 2 * 2048 * 32 * 4;
constexpr size_t WS_WUQ = WS_WIN + (size_t)2 * INP * 2048 * 2;
constexpr size_t WS_WUK = WS_WUQ + (size_t)2 * 1536 * 512 * 2;
constexpr size_t WS_WUV = WS_WUK + (size_t)2 * 1024 * 256 * 2;
constexpr size_t WS_WGT = WS_WUV + (size_t)2 * 1024 * 256 * 2;
constexpr size_t WS_WOUT = WS_WGT + (size_t)2 * 2048 * 256 * 2;
constexpr size_t WS_WPOOL = WS_WOUT + (size_t)2 * 2048 * 2048 * 2;
constexpr size_t WS_WQ = WS_WPOOL + (size_t)2 * 2048 * 512 * 2;
constexpr size_t WS_WK = WS_WQ + (size_t)4 * 2048 * 2048 * 2;
constexpr size_t WS_WV = WS_WK + (size_t)4 * 2048 * 2048 * 2;
constexpr size_t WS_WO = WS_WV + (size_t)4 * 2048 * 2048 * 2;
constexpr size_t WS_WUP = WS_WO + (size_t)4 * 2048 * 2048 * 2;
constexpr size_t WS_WDN = WS_WUP + (size_t)4 * 8192 * 2048 * 2;
constexpr size_t WS_XF = WS_WDN + (size_t)4 * 8192 * 2048 * 2;
constexpr size_t WS_XB = WS_XF + (size_t)R * D * 4;
constexpr size_t WS_TB = WS_XB + (size_t)RPAD * D * 2;
constexpr size_t WS_MEMK = WS_TB + (size_t)R * D * 4;
constexpr size_t WS_MEMVT = WS_MEMK + (size_t)4 * 12 * 256 * 2048 * 2;
constexpr size_t WS_CKV = WS_MEMVT + (size_t)4 * 12 * 256 * 2048 * 2;
constexpr size_t WS_KPE = WS_CKV + (size_t)2 * KEYSPAD * 256 * 2;
constexpr size_t WS_MEMBF = WS_KPE + (size_t)2 * KEYSPAD * 64 * 2;
constexpr size_t WS_SCR = al(WS_MEMBF + (size_t)1024 * 2048 * 2);
constexpr size_t WS_ZB = WS_SCR;
constexpr size_t WS_UCB = WS_ZB + (size_t)R * INP * 2;
constexpr size_t WS_CQN = WS_UCB + (size_t)RPAD * 1024 * 2;
constexpr size_t WS_GAT = WS_CQN + (size_t)RPAD * 512 * 2;
constexpr size_t WS_Q = WS_GAT + (size_t)R * 2048 * 2;
constexpr size_t WS_KN = WS_Q + (size_t)RPAD * 1536 * 2;
constexpr size_t WS_VT = WS_KN + (size_t)KEYSPAD * 1024 * 2;
constexpr size_t WS_MIX = al(WS_VT + (size_t)1024 * KEYS * 2 + 4096);
constexpr size_t WS_SCR_END1 = WS_MIX + (size_t)RPAD * 2048 * 2;
constexpr size_t WS_QX = WS_SCR;
constexpr size_t WS_E = WS_QX + (size_t)RPAD * 2048 * 2;
constexpr size_t WS_RS4 = WS_E + (size_t)RPAD * 1024 * 2;
constexpr size_t WS_OX = WS_RS4 + (size_t)R * 16 * 4;
constexpr size_t WS_SCR_END2 = WS_OX + (size_t)RPAD * 2048 * 2;
static_assert(WS_SCR_END2 <= WS_Q, "cross scratch must stay inside the dead mixer buffers");
constexpr size_t WS_HB = WS_SCR;
constexpr size_t WS_SCR_END3 = WS_HB + (size_t)RPAD * DFF * 2;
constexpr size_t WS_END = (WS_SCR_END1 > WS_SCR_END3 ? WS_SCR_END1 : WS_SCR_END3) + 4096;
static_assert(WS_END < (1ull << 32), "GEMM operand offsets are 32-bit");

struct Params {
    const float* in[34];
    float* out;
    unsigned char* ws;
    int ph_lo, ph_hi;
};

constexpr int HTB = 128 * 64 * 2;
DI int lds_byte(int r, int c) { const int st = (r >> 4) * 2 + (c >> 5), rr = r & 15, cc = c & 31, ob = rr * 64 + cc * 2; return st * 1024 + (ob ^ (((ob >> 9) & 1) << 5)); }
DI void stage_rc(int b, int& Rr, int& C) { const int st = b / 1024, sb = b % 1024, swz = sb ^ (((sb >> 9) & 1) << 5); Rr = (st >> 1) * 16 + swz / 64; C = (st & 1) * 32 + (swz % 64) / 2; }
DI int perm32(int rho) { const int n = rho >> 4, i = rho & 15; return 8 * (i >> 2) + 4 * n + (i & 3); }

struct GUnit { unsigned A, B; long ooff; long ooff2; int r0, c0, nvalid, aux; };

template <class Epi, class Dec>
DI void gemm_phase(const int wave_id, const char* wsb, LAS unsigned char* lds, const int K, const int lda, const int ldb, const int first, const int stride, const int count, const Dec& Dc, const Epi& E) {
    const int lane = lane_id_asm(), wid = wave_id, tid = wid * 64 + lane,
               wr = wid >> 2, wc = wid & 3, fr = lane & 15, fq = lane >> 4;
    const int nt = K / 64;
    __builtin_amdgcn_s_waitcnt(0);
    if (first >= count) return;
    unsigned voffA[2], voffB[2];
#pragma unroll
    for (int i = 0; i < 2; ++i) { int Rr, C; stage_rc(tid * 16 + i * 8192, Rr, C); const int Rb = Epi::PERM ? ((Rr & ~31) + perm32(Rr & 31)) : Rr;
        voffA[i] = (unsigned)(Rr * lda + C) * 2u; voffB[i] = (unsigned)(Rb * ldb + C) * 2u; }
    const unsigned kstep = 128u;
    const unsigned hstepA = 128u * (unsigned)lda * 2u, hstepB = 128u * (unsigned)ldb * 2u;
    const unsigned ldsw = (unsigned)wid * 1024u;
    const int aoff = lds_byte(wr * 64 + fr, fq * 8), boff = lds_byte(wc * 32 + fr, fq * 8);
#define PG8_SA(b, h) (((b) * 2 + (h)) * HTB)
#define PG8_SB(b, h) ((4 + (b) * 2 + (h)) * HTB)
#define PG8_STAGE(bufoff, gbase, voff) do { _Pragma("unroll") for (int _i = 0; _i < 2; ++_i) \
        __builtin_amdgcn_global_load_lds((const unsigned*)(wsb + (size_t)(unsigned)((gbase) + (voff)[_i])), (LAS unsigned*)(lds + (bufoff) + ldsw + _i * 8192), 16, 0, 0); } while (0)
#define PG8_LDA(dst, b, h) do { _Pragma("unroll") for (int m = 0; m < 4; ++m) _Pragma("unroll") for (int k = 0; k < 2; ++k) dst[m][k] = *(const LAS bf16x8*)(lds + PG8_SA(b, h) + aoff + m * 2048 + k * 1024); } while (0)
#define PG8_LDB(dst, b, h) do { _Pragma("unroll") for (int n = 0; n < 2; ++n) _Pragma("unroll") for (int k = 0; k < 2; ++k) dst[n][k] = *(const LAS bf16x8*)(lds + PG8_SB(b, h) + boff + n * 2048 + k * 1024); } while (0)
#define PG8_MMA(ai, bj, At, Bt) do { __builtin_amdgcn_s_setprio(1); _Pragma("unroll") for (int m = 0; m < 4; ++m) _Pragma("unroll") for (int n = 0; n < 2; ++n) _Pragma("unroll") for (int k = 0; k < 2; ++k) \
        acc[ai][bj][m][n] = __builtin_amdgcn_mfma_f32_16x16x32_bf16(Bt[n][k], At[m][k], acc[ai][bj][m][n], 0, 0, 0); __builtin_amdgcn_s_setprio(0); } while (0)
#define PG8_WAIT_V(n) asm volatile("s_waitcnt vmcnt(" #n ")" ::: "memory")
#define PG8_WAIT_L(n) asm volatile("s_waitcnt lgkmcnt(" #n ")" ::: "memory")
#define PG8_BAR __builtin_amdgcn_s_barrier()
#define PG8_SCHED __builtin_amdgcn_sched_barrier(0)
    int L = first;
    unsigned cA, cB;
    { GUnit u0; Dc(L, u0); cA = u0.A; cB = u0.B; }
    f32x4 acc[2][2][4][2];
#pragma unroll
    for (int a = 0; a < 2; ++a)
#pragma unroll
        for (int b = 0; b < 2; ++b)
#pragma unroll
            for (int m = 0; m < 4; ++m)
#pragma unroll
                for (int n = 0; n < 2; ++n) acc[a][b][m][n] = (f32x4){0.f, 0.f, 0.f, 0.f};
    bf16x8 At[4][2], B0[2][2], B1[2][2];
    PG8_STAGE(PG8_SB(0, 0), cB, voffB); PG8_STAGE(PG8_SB(0, 1), cB + hstepB, voffB); PG8_STAGE(PG8_SA(0, 0), cA, voffA); PG8_STAGE(PG8_SA(0, 1), cA + hstepA, voffA);
    if (wr == 1) PG8_BAR;
    PG8_WAIT_V(2); PG8_BAR;
    PG8_STAGE(PG8_SB(1, 0), cB + kstep, voffB); PG8_STAGE(PG8_SA(1, 0), cA + kstep, voffA); PG8_STAGE(PG8_SB(1, 1), cB + hstepB + kstep, voffB);
    PG8_WAIT_V(6); PG8_BAR;
    for (;;) {
        const bool has_next = (L + stride) < count;
        unsigned nA = cA, nB = cB;
        if (has_next) { GUnit un; Dc(L + stride, un); nA = un.A; nB = un.B; }
        for (int t = 0; t < nt; t += 2) {
            const bool last = (t == nt - 2);
            const unsigned a1 = cA + (unsigned)(t + 1) * kstep;
            const unsigned a2 = last ? nA : cA + (unsigned)(t + 2) * kstep; const unsigned b2 = last ? nB : cB + (unsigned)(t + 2) * kstep;
            const unsigned a3 = a2 + kstep, b3 = b2 + kstep;
            PG8_LDB(B0, 0, 0); PG8_LDB(B1, 0, 1); PG8_SCHED; PG8_LDA(At, 0, 0); PG8_STAGE(PG8_SA(1, 1), a1 + hstepA, voffA);
            PG8_WAIT_V(8); PG8_WAIT_L(0); PG8_BAR; PG8_MMA(0, 0, At, B0); PG8_MMA(0, 1, At, B1); PG8_BAR; PG8_SCHED;
            PG8_LDA(At, 0, 1); PG8_STAGE(PG8_SB(0, 0), b2, voffB); PG8_STAGE(PG8_SB(0, 1), b2 + hstepB, voffB); PG8_STAGE(PG8_SA(0, 0), a2, voffA);
            PG8_WAIT_V(8); PG8_WAIT_L(0); PG8_BAR; PG8_MMA(1, 0, At, B0); PG8_MMA(1, 1, At, B1); PG8_BAR; PG8_SCHED;
            PG8_LDB(B0, 1, 0); PG8_LDB(B1, 1, 1); PG8_SCHED; PG8_LDA(At, 1, 0); PG8_STAGE(PG8_SA(0, 1), a2 + hstepA, voffA);
            PG8_WAIT_V(8); PG8_WAIT_L(0); PG8_BAR; PG8_MMA(0, 0, At, B0); PG8_MMA(0, 1, At, B1); PG8_BAR; PG8_SCHED;
            PG8_LDA(At, 1, 1); PG8_STAGE(PG8_SB(1, 0), b3, voffB); PG8_STAGE(PG8_SB(1, 1), b3 + hstepB, voffB); PG8_STAGE(PG8_SA(1, 0), a3, voffA);
            PG8_WAIT_V(8); PG8_WAIT_L(0); PG8_BAR; PG8_MMA(1, 0, At, B0); PG8_MMA(1, 1, At, B1); PG8_BAR; PG8_SCHED;
        }
        if (wr == 0) PG8_BAR;
        { GUnit uc; Dc(L, uc); int fr2 = fr, fq2 = fq; asm volatile("" : "+v"(fr2), "+v"(fq2)); E(acc, uc, wr, wc, fr2, fq2); }
        if (!has_next) break;
#pragma unroll
        for (int a = 0; a < 2; ++a)
#pragma unroll
            for (int b = 0; b < 2; ++b)
#pragma unroll
                for (int m = 0; m < 4; ++m)
#pragma unroll
                    for (int n = 0; n < 2; ++n) acc[a][b][m][n] = (f32x4){0.f, 0.f, 0.f, 0.f};
        cA = nA; cB = nB; L += stride;
        if (wr == 1) PG8_BAR;
    }
    PG8_WAIT_V(0);
    PG8_BAR;
#undef PG8_SA
#undef PG8_SB
#undef PG8_STAGE
#undef PG8_LDA
#undef PG8_LDB
#undef PG8_MMA
#undef PG8_WAIT_V
#undef PG8_WAIT_L
#undef PG8_BAR
#undef PG8_SCHED
}

enum { BF_PLAIN = 0, BF_SIGMOID = 1, BF_ROPE = 2, BF_EXP = 3, BF_DIV = 4, BF_RELU2 = 5 };
template <int MODE> struct EpiBF {
    static constexpr bool PERM = true;
    bf16_t* O; int ldc;
    const float* bias;
    const float* rcos; const float* rsin;
    float* rs4;
    float scale;
    DI void operator()(const f32x4 (&acc)[2][2][4][2], const GUnit& u, int wr, int wc, int fr, int fq) const {
#pragma unroll
        for (int ai = 0; ai < 2; ++ai)
#pragma unroll
            for (int m = 0; m < 4; ++m) {
                const int r = ai * 128 + wr * 64 + m * 16 + fr;
                const bool ok = r < u.nvalid;
                float rsum = 0.f, inv = 1.f; int pos = 0;
                if (MODE == BF_DIV) { const f32x4 p = *(const f32x4*)(rs4 + ((size_t)(u.r0 + r) * 4 + u.aux) * 4); inv = 1.0f / ((p[0] + p[1]) + (p[2] + p[3])); }
                if (MODE == BF_ROPE) { const int gr = u.r0 + r; pos = gr < RP ? (gr & 2047) : 1024 + ((gr - RP) & 31); }
#pragma unroll
                for (int bj = 0; bj < 2; ++bj) {
                    const int c = bj * 128 + wc * 32 + fq * 8;
                    f32x4 v0 = acc[ai][bj][m][0], v1 = acc[ai][bj][m][1];
                    if (MODE == BF_SIGMOID) {
                        const f32x4 b0 = *(const f32x4*)(bias + u.c0 + c), b1 = *(const f32x4*)(bias + u.c0 + c + 4);
#pragma unroll
                        for (int j = 0; j < 4; ++j) { v0[j] = 1.0f / (1.0f + __expf(-(v0[j] + b0[j]))); v1[j] = 1.0f / (1.0f + __expf(-(v1[j] + b1[j]))); }
                    }
                    if (MODE == BF_ROPE) {
                        const int dd = (u.c0 + c) % 192;
                        if (dd >= 128) {
                            const int i0 = (dd - 128) >> 1;
                            const f32x4 cs = *(const f32x4*)(rcos + pos * 32 + i0), sn = *(const f32x4*)(rsin + pos * 32 + i0);
                            const float a0 = v0[0] * cs[0] - v0[1] * sn[0], a1 = v0[0] * sn[0] + v0[1] * cs[0];
                            const float a2 = v0[2] * cs[1] - v0[3] * sn[1], a3 = v0[2] * sn[1] + v0[3] * cs[1];
                            const float b0 = v1[0] * cs[2] - v1[1] * sn[2], b1 = v1[0] * sn[2] + v1[1] * cs[2];
                            const float b2 = v1[2] * cs[3] - v1[3] * sn[3], b3 = v1[2] * sn[3] + v1[3] * cs[3];
                            v0 = (f32x4){a0, a1, a2, a3}; v1 = (f32x4){b0, b1, b2, b3};
                        }
                    }
                    if (MODE == BF_EXP) {
#pragma unroll
                        for (int j = 0; j < 4; ++j) { v0[j] = __expf(v0[j] * scale); v1[j] = __expf(v1[j] * scale); }
                        rsum += ((v0[0] + v0[1]) + (v0[2] + v0[3])) + ((v1[0] + v1[1]) + (v1[2] + v1[3]));
                    }
                    if (MODE == BF_DIV) { v0 *= inv; v1 *= inv; }
                    if (MODE == BF_RELU2) {
#pragma unroll
                        for (int j = 0; j < 4; ++j) { const float a = fmaxf(v0[j], 0.f), b = fmaxf(v1[j], 0.f); v0[j] = a * a; v1[j] = b * b; }
                    }
                    u32x4 w; w.x = pk2(v0[0], v0[1]); w.y = pk2(v0[2], v0[3]); w.z = pk2(v1[0], v1[1]); w.w = pk2(v1[2], v1[3]);
                    if (ok) *(u32x4*)(O + u.ooff + (size_t)r * ldc + c) = w;
                }
                if (MODE == BF_EXP) {
                    rsum += __shfl_xor(rsum, 16); rsum += __shfl_xor(rsum, 32);
                    if (fq == 0 && ok) rs4[((size_t)(u.r0 + r) * 4 + u.aux) * 4 + wc] = rsum;
                }
                asm volatile("" ::: "memory");
            }
    }
};
enum { F_RESID = 0, F_MEMKV = 1 };
template <int MODE> struct EpiF32 {
    static constexpr bool PERM = false;
    float* O; int ldc;
    const float* X;
    const float* scale;
    bf16_t* O2; int ldc2;
    DI void operator()(const f32x4 (&acc)[2][2][4][2], const GUnit& u, int wr, int wc, int fr, int fq) const {
#pragma unroll
        for (int ai = 0; ai < 2; ++ai)
#pragma unroll
            for (int m = 0; m < 4; ++m) {
                const int r = ai * 128 + wr * 64 + m * 16 + fr;
#pragma unroll
                for (int bj = 0; bj < 2; ++bj)
#pragma unroll
                    for (int n = 0; n < 2; ++n) {
                        const int c = bj * 128 + wc * 32 + n * 16 + fq * 4;
                        const size_t off = (size_t)u.ooff + (size_t)r * ldc + c;
                        f32x4 v = acc[ai][bj][m][n];
                        if (MODE == F_RESID) {
                            const f32x4 x = *(const f32x4*)(X + off);
                            if (scale) v *= *(const f32x4*)(scale + u.c0 + c);
                            v = x * DN_ALPHA + v;
                            *(f32x4*)(O + off) = v;
                        } else {
                            *(f32x4*)(O + off) = v;
                            if (u.ooff2 >= 0) { u32x2 w; w.x = pk2(v[0], v[1]); w.y = pk2(v[2], v[3]); *(u32x2*)(O2 + (size_t)u.ooff2 + (size_t)r * ldc2 + c) = w; }
                        }
                    }
                asm volatile("" ::: "memory");
            }
    }
};

DI void tile_of(int u, int nM, int nN, int& pm, int& pn) {
    const int nig = 8 * nN; const int gid = u / nig; const int fm = gid * 8; const int gsz = (nM - fm) < 8 ? (nM - fm) : 8; const int w = u - gid * nig; pm = fm + w % gsz; pn = w / gsz; }
struct DecDense {
    unsigned A, B; int lda, ldb, ldc, nM, nN, grp, acw;
    DI void operator()(int L, GUnit& u) const { int pm, pn; tile_of(L, nM, nN, pm, pn);
        u.A = A + (unsigned)(pm * 256 * lda + (pn / grp) * acw) * 2u; u.B = B + (unsigned)(pn * 256 * ldb) * 2u;
        u.ooff = (long)pm * 256 * ldc + (long)pn * 256; u.ooff2 = -1; u.r0 = pm * 256; u.c0 = pn * 256; u.nvalid = 256; u.aux = 0; }
};
struct DecMemKV {
    unsigned mem, wk, wv;
    DI void operator()(int L, GUnit& u) const { const int which = L >> 5, t = L & 31, l = which >> 1, kv = which & 1, pm = t & 3, pn = t >> 2;
        u.A = mem + (unsigned)(pm * 256 * 2048) * 2u; u.B = (kv ? wv : wk) + (unsigned)(l * 2048 * 2048 + pn * 256 * 2048) * 2u;
        u.ooff = (long)(kv ? O_PMEMV : O_PMEMK) + (long)l * 2097152 + (long)pm * 256 * 2048 + pn * 256;
        u.ooff2 = kv ? -1 : ((long)(l * 12 + pm) * 256 * 2048 + pn * 256);
        u.r0 = pm * 256; u.c0 = pn * 256; u.nvalid = 256; u.aux = 0; }
};
struct DecMemVT {
    unsigned wv, mem;
    DI void operator()(int L, GUnit& u) const { const int l = L >> 5, t = L & 31, pm = t & 7, pn = t >> 3;
        u.A = wv + (unsigned)(l * 2048 * 2048 + pm * 256 * 2048) * 2u; u.B = mem + (unsigned)(pn * 256 * 2048) * 2u;
        u.ooff = ((long)(l * 12 + pn) * 2048 + pm * 256) * 256; u.ooff2 = -1; u.r0 = pm * 256; u.c0 = 0; u.nvalid = 256; u.aux = 0; }
};
struct DecXS {
    unsigned qx, memk;
    DI void operator()(int L, GUnit& u) const {
        int sg, h, r0, nv;
        if (L < 128) { const int panel = L & 7, bh = L >> 3; h = bh & 3; sg = bh >> 2; r0 = sg * 2048 + panel * 256; nv = 256; }
        else { const int s = L - 128; h = s & 3; const int b = s >> 2; sg = 4 + b; r0 = RP + b * 32; nv = 32; }
        u.A = qx + (unsigned)(r0 * 2048 + h * 512) * 2u; u.B = memk + (unsigned)(sg * 256 * 2048 + h * 512) * 2u;
        u.ooff = (long)r0 * 1024 + h * 256; u.ooff2 = -1; u.r0 = r0; u.c0 = 0; u.nvalid = nv; u.aux = h; }
};
struct DecXPV {
    unsigned e, memvt;
    DI void operator()(int L, GUnit& u) const {
        int sg, h, half, r0, nv;
        if (L < 256) { const int panel = L & 7, x = L >> 3; half = x & 1; h = (x >> 1) & 3; sg = x >> 3; r0 = sg * 2048 + panel * 256; nv = 256; }
        else { const int s = L - 256; half = s & 1; h = (s >> 1) & 3; const int b = s >> 3; sg = 4 + b; r0 = RP + b * 32; nv = 32; }
        u.A = e + (unsigned)(r0 * 1024 + h * 256) * 2u; u.B = memvt + (unsigned)((sg * 2048 + h * 512 + half * 256) * 256) * 2u;
        u.ooff = (long)r0 * 2048 + h * 512 + half * 256; u.ooff2 = -1; u.r0 = r0; u.c0 = h * 512 + half * 256; u.nvalid = nv; u.aux = h; }
};

DI int first_of(int vcu, int G, int off) { int f = vcu - (off % G); return f < 0 ? f + G : f; }

struct Frame {
    LAS unsigned char* lds;
    int tid, lane, wave, G, vcu;
};
DI Frame refresh(const Frame& F0) { Frame F = F0; F.lane = lane_id_asm(); F.tid = F.wave * 64 + F.lane; return F; }

DI int uq_rowmap(int n) { const int h = n / 192, d = n - h * 192; if (d < 128) return n; const int e = d - 128; return h * 192 + 128 + 2 * (e & 31) + (e >> 5); }
DI void tr_job(const Frame& F, int& off, const float* src, int lds_, int K, int N, bf16_t* dst, int ldd, int dcol0, int rowmap) {
    LAS float* tile = (LAS float*)(F.lds + STAGE_OFF);
    const int tK = K / 128, tN = N / 128, nt = tK * tN;
    for (int t = first_of(F.vcu, F.G, off); t < nt; t += F.G) {
        const int tk = t / tN, tn = t - tk * tN;
        const float* s = src + (size_t)(tk * 128) * lds_ + tn * 128;
#pragma unroll
        for (int i = 0; i < 8; ++i) { const int idx = F.tid + i * 512; const int rr = idx >> 5, c4 = (idx & 31) * 4;
            const f32x4 v = *(const f32x4*)(s + (size_t)rr * lds_ + c4);
            tile[rr * 129 + c4 + 0] = v[0]; tile[rr * 129 + c4 + 1] = v[1]; tile[rr * 129 + c4 + 2] = v[2]; tile[rr * 129 + c4 + 3] = v[3]; }
        __syncthreads();
#pragma unroll
        for (int i = 0; i < 4; ++i) { const int idx = F.tid + i * 512; const int n = idx >> 4, k8 = (idx & 15) * 8;
            u32x4 w;
            w.x = pk2(tile[(k8 + 0) * 129 + n], tile[(k8 + 1) * 129 + n]); w.y = pk2(tile[(k8 + 2) * 129 + n], tile[(k8 + 3) * 129 + n]);
            w.z = pk2(tile[(k8 + 4) * 129 + n], tile[(k8 + 5) * 129 + n]); w.w = pk2(tile[(k8 + 6) * 129 + n], tile[(k8 + 7) * 129 + n]);
            const int ng = tn * 128 + n; const int nr = rowmap ? uq_rowmap(ng) : ng;
            *(u32x4*)(dst + (size_t)nr * ldd + dcol0 + tk * 128 + k8) = w; }
        __syncthreads();
    }
    off += nt;
}
DI void cvt_job(const Frame& F, const float* src, bf16_t* dst, float* dstf, size_t n) {
    const size_t n4 = n >> 2;
    for (size_t i = (size_t)F.vcu * 512 + F.tid; i < n4; i += (size_t)F.G * 512) {
        const f32x4 v = *(const f32x4*)(src + i * 4);
        u32x2 w; w.x = pk2(v[0], v[1]); w.y = pk2(v[2], v[3]);
        *(u32x2*)(dst + i * 4) = w;
        if (dstf) *(f32x4*)(dstf + i * 4) = v;
    }
}
DI void zero_job(const Frame& F, void* dst, size_t bytes) {
    const size_t n = bytes >> 4;
    for (size_t i = (size_t)F.vcu * 512 + F.tid; i < n; i += (size_t)F.G * 512) ((u32x4*)dst)[i] = (u32x4){0u, 0u, 0u, 0u};
}

DI void p0_prologue(const Frame& F0, const Params& p) {
    const Frame F = refresh(F0);
    unsigned char* ws = p.ws;
    int off = 0;
    for (int j = 0; j < 2; ++j) {
        tr_job(F, off, p.in[10] + (size_t)j * 2048 * INC, INC, 2048, 2816, (bf16_t*)(ws + WS_WIN) + (size_t)j * INP * 2048, 2048, 0, 0);
        tr_job(F, off, p.in[12] + (size_t)j * 512 * 1536, 1536, 512, 1536, (bf16_t*)(ws + WS_WUQ) + (size_t)j * 1536 * 512, 512, 0, 1);
        tr_job(F, off, p.in[14] + (size_t)j * 256 * 1024, 1024, 256, 1024, (bf16_t*)(ws + WS_WUK) + (size_t)j * 1024 * 256, 256, 0, 0);
        tr_job(F, off, p.in[15] + (size_t)j * 256 * 1024, 1024, 256, 1024, (bf16_t*)(ws + WS_WUV) + (size_t)j * 1024 * 256, 256, 0, 0);
        for (int h = 0; h < 8; ++h) {
            bf16_t* g = (bf16_t*)(ws + WS_WGT) + (size_t)j * 2048 * 256 + (size_t)h * 256 * 256;
            tr_job(F, off, p.in[18] + ((size_t)j * 8 + h) * 128 * 128, 128, 128, 128, g, 256, (h & 1) * 128, 0);
            tr_job(F, off, p.in[20] + ((size_t)j * 8 + h) * 128 * 128, 128, 128, 128, g + 128 * 256, 256, (h & 1) * 128, 0);
        }
        tr_job(F, off, p.in[23] + (size_t)j * 2048 * 2048, 2048, 2048, 2048, (bf16_t*)(ws + WS_WOUT) + (size_t)j * 2048 * 2048, 2048, 0, 0);
        for (int g = 0; g < 4; ++g)
            tr_job(F, off, p.in[24] + ((size_t)j * 4 + g) * 512 * 512, 512, 512, 512, (bf16_t*)(ws + WS_WPOOL) + (size_t)j * 2048 * 512 + (size_t)g * 512 * 512, 512, 0, 0);
    }
    for (int l = 0; l < 4; ++l) {
        tr_job(F, off, p.in[26] + (size_t)l * 2048 * 2048, 2048, 2048, 2048, (bf16_t*)(ws + WS_WQ) + (size_t)l * 2048 * 2048, 2048, 0, 0);
        tr_job(F, off, p.in[27] + (size_t)l * 2048 * 2048, 2048, 2048, 2048, (bf16_t*)(ws + WS_WK) + (size_t)l * 2048 * 2048, 2048, 0, 0);
        tr_job(F, off, p.in[28] + (size_t)l * 2048 * 2048, 2048, 2048, 2048, (bf16_t*)(ws + WS_WV) + (size_t)l * 2048 * 2048, 2048, 0, 0);
        tr_job(F, off, p.in[29] + (size_t)l * 2048 * 2048, 2048, 2048, 2048, (bf16_t*)(ws + WS_WO) + (size_t)l * 2048 * 2048, 2048, 0, 0);
        tr_job(F, off, p.in[30] + (size_t)l * 2048 * 8192, 8192, 2048, 8192, (bf16_t*)(ws + WS_WUP) + (size_t)l * 8192 * 2048, 2048, 0, 0);
        tr_job(F, off, p.in[31] + (size_t)l * 8192 * 2048, 2048, 8192, 2048, (bf16_t*)(ws + WS_WDN) + (size_t)l * 2048 * 8192, 8192, 0, 0);
        for (int b = 0; b < 8; ++b)
            tr_job(F, off, p.in[4] + ((size_t)l * 8 + b) * 256 * 2048, 2048, 256, 2048, (bf16_t*)(ws + WS_MEMVT) + ((size_t)l * 12 + 4 + b) * 2048 * 256, 256, 0, 0);
        cvt_job(F, p.in[3] + (size_t)l * 8 * 256 * 2048, (bf16_t*)(ws + WS_MEMK) + ((size_t)l * 12 + 4) * 256 * 2048, nullptr, (size_t)8 * 256 * 2048);
    }
    for (int j = 0; j < 2; ++j) {
        const float* src = p.in[10] + (size_t)j * 2048 * INC; bf16_t* dst = (bf16_t*)(ws + WS_WIN) + (size_t)j * INP * 2048;
        for (int i = F.vcu * 512 + F.tid; i < 64 * 2048; i += F.G * 512) { const int k = i >> 6, n = 2816 + (i & 63); dst[(size_t)n * 2048 + k] = (bf16_t)(pk2(src[(size_t)k * INC + n], 0.f) & 0xffffu); }
        zero_job(F, dst + (size_t)INC * 2048, (size_t)(INP - INC) * 2048 * 2);
        bf16_t* g = (bf16_t*)(ws + WS_WGT) + (size_t)j * 2048 * 256;
        for (int i = F.vcu * 512 + F.tid; i < 2048 * 16; i += F.G * 512) { const int row = i >> 4, c8 = (i & 15) * 8; const int h = row >> 8; *(u32x4*)(g + (size_t)row * 256 + (1 - (h & 1)) * 128 + c8) = (u32x4){0u, 0u, 0u, 0u}; }
    }
    cvt_job(F, p.in[0], (bf16_t*)(ws + WS_XB), (float*)(ws + WS_XF), (size_t)RP * D);
    cvt_job(F, p.in[1], (bf16_t*)(ws + WS_XB) + (size_t)RP * D, (float*)(ws + WS_XF) + (size_t)RP * D, (size_t)RS * D);
    cvt_job(F, p.in[2], (bf16_t*)(ws + WS_MEMBF), nullptr, (size_t)1024 * 2048);
    for (int j = 0; j < 2; ++j) {
        bf16_t* ck = (bf16_t*)(ws + WS_CKV) + (size_t)j * KEYSPAD * 256; bf16_t* kp = (bf16_t*)(ws + WS_KPE) + (size_t)j * KEYSPAD * 64;
        const float* sck = p.in[5] + (size_t)j * 8 * 1024 * 256; const float* skp = p.in[6] + (size_t)j * 8 * 1024 * 64;
        for (int i = F.vcu * 512 + F.tid; i < 8 * 1024 * 64; i += F.G * 512) {
            const int row = i >> 6, c4 = (i & 63) * 4, b = row >> 10, t = row & 1023;
            const f32x4 v = *(const f32x4*)(sck + (size_t)row * 256 + c4); u32x2 w; w.x = pk2(v[0], v[1]); w.y = pk2(v[2], v[3]);
            *(u32x2*)(ck + (size_t)(RP + b * 1056 + t) * 256 + c4) = w; }
        for (int i = F.vcu * 512 + F.tid; i < 8 * 1024 * 32; i += F.G * 512) {
            const int row = i >> 5, ii = i & 31, b = row >> 10, t = row & 1023;
            const float x1 = skp[(size_t)row * 64 + ii], x2 = skp[(size_t)row * 64 + 32 + ii];
            *(unsigned*)(kp + (size_t)(RP + b * 1056 + t) * 64 + 2 * ii) = pk2(x1, x2); }
    }
    { float* gb = (float*)(ws + WS_CTL + 32768);
      for (int i = F.vcu * 512 + F.tid; i < 2 * 2048; i += F.G * 512) { const int jj = i >> 11, h = (i >> 8) & 7, e = i & 255;
          gb[i] = e < 128 ? p.in[19][((size_t)jj * 8 + h) * 128 + e] : p.in[21][((size_t)jj * 8 + h) * 128 + (e - 128)]; } }
    { float* rc = (float*)(ws + WS_ROPE); float* rsn = rc + 2048 * 32;
      for (int i = F.vcu * 512 + F.tid; i < 2048 * 32; i += F.G * 512) { const int pos = i >> 5, ii = i & 31;
          const float inv = powf(10000.0f, -(float)ii / 32.0f); const float ang = (float)pos * inv; rc[i] = (float)cos((double)ang); rsn[i] = (float)sin((double)ang); } }
}

DI void ln_phase(const Frame& F0, const float* tb, const float* g, const float* b, float* xf, bf16_t* xb) {
    const Frame F = refresh(F0);
    for (int r = F.vcu * 8 + F.wave; r < R; r += F.G * 8) {
        const float* src = tb + (size_t)r * D;
        f32x4 v[8]; float s = 0.f;
#pragma unroll
        for (int i = 0; i < 8; ++i) { v[i] = *(const f32x4*)(src + (i * 64 + F.lane) * 4); s += (v[i][0] + v[i][1]) + (v[i][2] + v[i][3]); }
#pragma unroll
        for (int o = 32; o >= 1; o >>= 1) s += __shfl_xor(s, o);
        const float mu = s * (1.0f / D); float q = 0.f;
#pragma unroll
        for (int i = 0; i < 8; ++i) { const f32x4 d = v[i] - mu; q += (d[0] * d[0] + d[1] * d[1]) + (d[2] * d[2] + d[3] * d[3]); }
#pragma unroll
        for (int o = 32; o >= 1; o >>= 1) q += __shfl_xor(q, o);
        const float rstd = rsqrtf(q * (1.0f / D) + LN_EPS);
#pragma unroll
        for (int i = 0; i < 8; ++i) { const int c = (i * 64 + F.lane) * 4;
            const f32x4 gg = *(const f32x4*)(g + c), bb = *(const f32x4*)(b + c);
            const f32x4 o = (v[i] - mu) * rstd * gg + bb;
            *(f32x4*)(xf + (size_t)r * D + c) = o;
            u32x2 w; w.x = pk2(o[0], o[1]); w.y = pk2(o[2], o[3]); *(u32x2*)(xb + (size_t)r * D + c) = w; }
    }
}

DI void e2_phase(const Frame& F0, const Params& p, int j) {
    const Frame F = refresh(F0);
    unsigned char* ws = p.ws;
    const bf16_t* zb = (const bf16_t*)(ws + WS_ZB);
    bf16_t* ucb = (bf16_t*)(ws + WS_UCB); bf16_t* cqn = (bf16_t*)(ws + WS_CQN);
    bf16_t* ckv = (bf16_t*)(ws + WS_CKV) + (size_t)j * KEYSPAD * 256; bf16_t* kpe = (bf16_t*)(ws + WS_KPE) + (size_t)j * KEYSPAD * 64;
    const float* rc = (const float*)(ws + WS_ROPE); const float* rsn = rc + 2048 * 32;
    const float* cw = p.in[16] + (size_t)j * 4 * 1024; const float* cb = p.in[17] + (size_t)j * 1024;
    const float* qg = p.in[11] + (size_t)j * 512; const float* kg = p.in[13] + (size_t)j * 256;
    const float* cst = p.in[8] + (size_t)j * 8 * 3 * 1024;
    const int lane = F.lane;
    for (int r = F.vcu * 8 + F.wave; r < R; r += F.G * 8) {
        const bool smp = r >= RP; const int b = smp ? ((r - RP) >> 5) : (r >> 11); const int t = smp ? ((r - RP) & 31) : (r & 2047);
        const int pos = smp ? 1024 + t : t; const int T = smp ? 32 : 2048;
        const bf16_t* zr = zb + (size_t)r * INP;
#pragma unroll
        for (int g = 0; g < 2; ++g) {
            const int c = g * 512 + lane * 8;
            float uu[4][8];
#pragma unroll
            for (int k = 0; k < 4; ++k) {
                const int tt = t - 3 + k;
                if (tt >= 0) { const u32x4 w = *(const u32x4*)(zr + (long)(k - 3) * INP + c);
                    uu[k][0] = bflo(w.x); uu[k][1] = bfhi(w.x); uu[k][2] = bflo(w.y); uu[k][3] = bfhi(w.y); uu[k][4] = bflo(w.z); uu[k][5] = bfhi(w.z); uu[k][6] = bflo(w.w); uu[k][7] = bfhi(w.w); }
                else if (smp) { const float* s = cst + ((size_t)b * 3 + (3 + tt)) * 1024 + c; const f32x4 a = *(const f32x4*)s, bq = *(const f32x4*)(s + 4);
                    uu[k][0] = a[0]; uu[k][1] = a[1]; uu[k][2] = a[2]; uu[k][3] = a[3]; uu[k][4] = bq[0]; uu[k][5] = bq[1]; uu[k][6] = bq[2]; uu[k][7] = bq[3]; }
                else {
#pragma unroll
                    for (int e = 0; e < 8; ++e) uu[k][e] = 0.f; }
            }
            float o[8];
#pragma unroll
            for (int e = 0; e < 8; ++e) o[e] = cb[c + e];
#pragma unroll
            for (int k = 0; k < 4; ++k)
#pragma unroll
                for (int e = 0; e < 8; ++e) o[e] += cw[k * 1024 + c + e] * uu[k][e];
            u32x4 w; w.x = pk2(o[0], o[1]); w.y = pk2(o[2], o[3]); w.z = pk2(o[4], o[5]); w.w = pk2(o[6], o[7]);
            *(u32x4*)(ucb + (size_t)r * 1024 + c) = w;
            if (t >= T - 3) {
                float* dst = smp ? (p.out + O_SCONV + (((size_t)j * 8 + b) * 3 + (t - (T - 3))) * 1024 + c) : (p.out + O_PCONV + (((size_t)j * 4 + b) * 3 + (t - (T - 3))) * 1024 + c);
                *(f32x4*)dst = (f32x4){uu[3][0], uu[3][1], uu[3][2], uu[3][3]}; *(f32x4*)(dst + 4) = (f32x4){uu[3][4], uu[3][5], uu[3][6], uu[3][7]};
            }
        }
        {
            const u32x4 w = *(const u32x4*)(zr + 2048 + lane * 8);
            float x[8] = {bflo(w.x), bfhi(w.x), bflo(w.y), bfhi(w.y), bflo(w.z), bfhi(w.z), bflo(w.w), bfhi(w.w)};
            float ss = 0.f;
#pragma unroll
            for (int e = 0; e < 8; ++e) ss += x[e] * x[e];
#pragma unroll
            for (int o = 32; o >= 1; o >>= 1) ss += __shfl_xor(ss, o);
            const float rs = rsqrtf(ss * (1.0f / 512.0f) + RMS_EPS);
            const f32x4 g0 = *(const f32x4*)(qg + lane * 8), g1 = *(const f32x4*)(qg + lane * 8 + 4);
            u32x4 ow; ow.x = pk2(x[0] * rs * g0[0], x[1] * rs * g0[1]); ow.y = pk2(x[2] * rs * g0[2], x[3] * rs * g0[3]);
            ow.z = pk2(x[4] * rs * g1[0], x[5] * rs * g1[1]); ow.w = pk2(x[6] * rs * g1[2], x[7] * rs * g1[3]);
            *(u32x4*)(cqn + (size_t)r * 512 + lane * 8) = ow;
        }
        const size_t krow = smp ? (size_t)(RP + b * 1056 + 1024 + t) : (size_t)r;
        {
            const u32x2 w = *(const u32x2*)(zr + 2560 + lane * 4);
            float x[4] = {bflo(w.x), bfhi(w.x), bflo(w.y), bfhi(w.y)};
            float ss = (x[0] * x[0] + x[1] * x[1]) + (x[2] * x[2] + x[3] * x[3]);
#pragma unroll
            for (int o = 32; o >= 1; o >>= 1) ss += __shfl_xor(ss, o);
            const float rs = rsqrtf(ss * (1.0f / 256.0f) + RMS_EPS);
            const f32x4 g0 = *(const f32x4*)(kg + lane * 4);
            const f32x4 o = (f32x4){x[0] * rs * g0[0], x[1] * rs * g0[1], x[2] * rs * g0[2], x[3] * rs * g0[3]};
            float* dst = smp ? (p.out + O_SCKV + (((size_t)j * 8 + b) * 32 + t) * 256 + lane * 4) : (p.out + O_PCKV + (((size_t)j * 4 + b) * 2048 + t) * 256 + lane * 4);
            *(f32x4*)dst = o;
            u32x2 ow; ow.x = pk2(o[0], o[1]); ow.y = pk2(o[2], o[3]); *(u32x2*)(ckv + krow * 256 + lane * 4) = ow;
        }
        if (lane < 32) {
            const float x1 = bf2f(zr[2816 + lane]), x2 = bf2f(zr[2816 + 32 + lane]);
            const float cs = rc[pos * 32 + lane], sn = rsn[pos * 32 + lane];
            const float o1 = x1 * cs - x2 * sn, o2 = x1 * sn + x2 * cs;
            float* dst = smp ? (p.out + O_SKPE + (((size_t)j * 8 + b) * 32 + t) * 64) : (p.out + O_PKPE + (((size_t)j * 4 + b) * 2048 + t) * 64);
            dst[lane] = o1; dst[32 + lane] = o2;
            *(unsigned*)(kpe + krow * 64 + 2 * lane) = pk2(o1, o2);
        }
    }
}

DI float gelu_tanh(float x) { const float y = 0.7978845608028654f * (x + 0.044715f * x * x * x); const float e = __expf(2.0f * y); const float th = 1.0f - 2.0f / (e + 1.0f); return 0.5f * x * (1.0f + th); }
DI void scan_phase(const Frame& F0, const Params& p, int j) {
    const Frame F = refresh(F0);
    unsigned char* ws = p.ws;
    const bf16_t* zb = (const bf16_t*)(ws + WS_ZB); const bf16_t* ucb = (const bf16_t*)(ws + WS_UCB); const bf16_t* gat = (const bf16_t*)(ws + WS_GAT);
    bf16_t* mix = (bf16_t*)(ws + WS_MIX);
    const float* lam = p.in[22] + (size_t)j * 1024;
    LAS float* sA = (LAS float*)(F.lds + STAGE_OFF); LAS float* sB = sA + 512;
    for (int task = F.vcu; task < 272; task += F.G) {
        if (task < 256) {
            const int b = task >> 6, cbk = task & 63, seg = F.tid >> 4, ch = cbk * 16 + (F.tid & 15);
            const float clam = -8.0f * log1pf(expf(-lam[ch]));
            const size_t row0 = (size_t)b * 2048 + seg * 64;
            const bf16_t* pr = gat + row0 * 2048 + (ch >> 7) * 256 + (ch & 127);
            const bf16_t* pu = ucb + row0 * 1024 + ch;
            float h = 0.f, Aacc = 1.f;
#pragma unroll 8
            for (int s = 0; s < 64; ++s) {
                const float rr = bf2f(pr[(size_t)s * 2048]), ig = bf2f(pr[(size_t)s * 2048 + 128]), u = bf2f(pu[(size_t)s * 1024]);
                const float la = clam * rr, a = __expf(la), mult = sqrtf(-expm1f(2.0f * la));
                h = a * h + mult * (ig * u); Aacc *= a;
            }
            sA[seg * 16 + (F.tid & 15)] = Aacc; sB[seg * 16 + (F.tid & 15)] = h;
            __syncthreads();
            float hin = 0.f;
            for (int s2 = 0; s2 < seg; ++s2) hin = sA[s2 * 16 + (F.tid & 15)] * hin + sB[s2 * 16 + (F.tid & 15)];
            h = hin;
            const bf16_t* pg = zb + row0 * INP + 1024 + ch;
            bf16_t* po = mix + row0 * 2048 + ch;
#pragma unroll 8
            for (int s = 0; s < 64; ++s) {
                const float rr = bf2f(pr[(size_t)s * 2048]), ig = bf2f(pr[(size_t)s * 2048 + 128]), u = bf2f(pu[(size_t)s * 1024]), gt = bf2f(pg[(size_t)s * INP]);
                const float la = clam * rr, a = __expf(la), mult = sqrtf(-expm1f(2.0f * la));
                h = a * h + mult * (ig * u);
                po[(size_t)s * 2048] = (bf16_t)(pk2(h * gelu_tanh(gt), 0.f) & 0xffffu);
            }
            if (seg == 31) p.out[O_PH + ((size_t)j * 4 + b) * 1024 + ch] = h;
            __syncthreads();
        } else {
            const int s0 = task - 256, b = s0 >> 1, ch = (s0 & 1) * 512 + F.tid;
            const float clam = -8.0f * log1pf(expf(-lam[ch]));
            const size_t row0 = (size_t)RP + b * 32;
            const bf16_t* pr = gat + row0 * 2048 + (ch >> 7) * 256 + (ch & 127);
            const bf16_t* pu = ucb + row0 * 1024 + ch;
            const bf16_t* pg = zb + row0 * INP + 1024 + ch;
            bf16_t* po = mix + row0 * 2048 + ch;
            float h = p.in[7][((size_t)j * 8 + b) * 1024 + ch];
#pragma unroll 8
            for (int s = 0; s < 32; ++s) {
                const float rr = bf2f(pr[(size_t)s * 2048]), ig = bf2f(pr[(size_t)s * 2048 + 128]), u = bf2f(pu[(size_t)s * 1024]), gt = bf2f(pg[(size_t)s * INP]);
                const float la = clam * rr, a = __expf(la), mult = sqrtf(-expm1f(2.0f * la));
                h = a * h + mult * (ig * u);
                po[(size_t)s * 2048] = (bf16_t)(pk2(h * gelu_tanh(gt), 0.f) & 0xffffu);
            }
            p.out[O_SH + ((size_t)j * 8 + b) * 1024 + ch] = h;
        }
    }
}

constexpr int AT_KROW = 400, AT_VROW = 136, AT_KBYTES = 64 * AT_KROW, AT_VBYTES = 128 * AT_VROW, AT_BUF = 44032;
DI void attn_phase(const Frame& F0, const Params& p, int j) {
    const Frame F = refresh(F0);
    unsigned char* ws = p.ws;
    const bf16_t* Q = (const bf16_t*)(ws + WS_Q); const bf16_t* Kn = (const bf16_t*)(ws + WS_KN); const bf16_t* VT = (const bf16_t*)(ws + WS_VT);
    const bf16_t* kpe = (const bf16_t*)(ws + WS_KPE) + (size_t)j * KEYSPAD * 64;
    bf16_t* mix = (bf16_t*)(ws + WS_MIX);
    const int tid = F.tid, w = F.wave, lane = F.lane, r32 = lane & 31, hf = lane >> 5;
    for (int slot = F.vcu; slot < 512; slot += F.G) {
        const int item = slot < 256 ? slot : 767 - slot;
        if (item >= 320) continue;
        int h, qrow0, kb0, ntiles, my_tiles, nkeys;
        if (item < 256) { const int qb = 7 - (item >> 5), rem = item & 31, b = rem >> 3; h = rem & 7;
            qrow0 = b * 2048 + qb * 256 + w * 32; kb0 = b * 2048; ntiles = qb * 4 + 4; my_tiles = qb * 4 + (w >> 1) + 1; nkeys = ntiles * 64; }
        else { const int s = item - 256, b = s >> 3; h = s & 7; qrow0 = RP + b * 32; kb0 = RP + b * 1056; ntiles = 17; my_tiles = (w == 0) ? 17 : 0; nkeys = 1056; }
        bf16x8 qf[12];
        if (my_tiles > 0) {
#pragma unroll
            for (int ks = 0; ks < 12; ++ks) qf[ks] = *(const bf16x8*)(Q + (size_t)(qrow0 + r32) * 1536 + h * 192 + ks * 16 + hf * 8);
        } else {
#pragma unroll
            for (int ks = 0; ks < 12; ++ks) qf[ks] = (bf16x8){0, 0, 0, 0, 0, 0, 0, 0};
        }
        u32x4 kreg[3], vreg[2];
#define AT_LOAD_TILE(kt_) do { \
            _Pragma("unroll") for (int i_ = 0; i_ < 3; ++i_) { const int q_ = tid + 512 * i_; const int key_ = q_ / 24, part_ = q_ - key_ * 24; \
                int kk_ = (kt_) * 64 + key_; kk_ = kk_ < nkeys ? kk_ : nkeys - 1; const size_t krow_ = (size_t)kb0 + kk_; \
                const bf16_t* src_ = part_ < 16 ? (Kn + krow_ * 1024 + h * 128 + part_ * 8) : (kpe + krow_ * 64 + (part_ - 16) * 8); \
                kreg[i_] = *(const u32x4*)src_; } \
            _Pragma("unroll") for (int i_ = 0; i_ < 2; ++i_) { const int q_ = tid + 512 * i_; const int dv_ = q_ >> 3, part_ = q_ & 7; \
                int kc_ = (kt_) * 64 + part_ * 8; kc_ = kc_ <= nkeys - 8 ? kc_ : nkeys - 8; \
                vreg[i_] = *(const u32x4*)(VT + (size_t)(h * 128 + dv_) * KEYS + kb0 + kc_); } } while (0)
#define AT_STORE_TILE(buf_) do { \
            LAS unsigned char* kb_ = F.lds + STAGE_OFF + (buf_) * AT_BUF; LAS unsigned char* vb_ = kb_ + AT_KBYTES; \
            _Pragma("unroll") for (int i_ = 0; i_ < 3; ++i_) { const int q_ = tid + 512 * i_; const int key_ = q_ / 24, part_ = q_ - key_ * 24; *(LAS u32x4*)(kb_ + key_ * AT_KROW + part_ * 16) = kreg[i_]; } \
            _Pragma("unroll") for (int i_ = 0; i_ < 2; ++i_) { const int q_ = tid + 512 * i_; const int dv_ = q_ >> 3, part_ = q_ & 7; \
                *(LAS u32x2*)(vb_ + dv_ * AT_VROW + part_ * 16) = (u32x2){vreg[i_].x, vreg[i_].y}; *(LAS u32x2*)(vb_ + dv_ * AT_VROW + part_ * 16 + 8) = (u32x2){vreg[i_].z, vreg[i_].w}; } } while (0)
        f32x16 o[4];
#pragma unroll
        for (int d = 0; d < 4; ++d)
#pragma unroll
            for (int i = 0; i < 16; ++i) o[d][i] = 0.f;
        float m_run = -INFINITY, l_run = 0.f;
        AT_LOAD_TILE(0); AT_STORE_TILE(0);
        __syncthreads();
        for (int kt = 0; kt < ntiles; ++kt) {
            const int buf = kt & 1;
            if (kt + 1 < ntiles) AT_LOAD_TILE(kt + 1);
            if (kt < my_tiles) {
                const LAS unsigned char* kb = F.lds + STAGE_OFF + buf * AT_BUF; const LAS unsigned char* vb = kb + AT_KBYTES;
                f32x16 s0, s1;
#pragma unroll
                for (int i = 0; i < 16; ++i) { s0[i] = 0.f; s1[i] = 0.f; }
#pragma unroll
                for (int ks = 0; ks < 12; ++ks) {
                    const bf16x8 a0 = *(const LAS bf16x8*)(kb + r32 * AT_KROW + ks * 32 + hf * 16);
                    const bf16x8 a1 = *(const LAS bf16x8*)(kb + (32 + r32) * AT_KROW + ks * 32 + hf * 16);
                    s0 = __builtin_amdgcn_mfma_f32_32x32x16_bf16(a0, qf[ks], s0, 0, 0, 0);
                    s1 = __builtin_amdgcn_mfma_f32_32x32x16_bf16(a1, qf[ks], s1, 0, 0, 0);
                }
                const float sc = 0.07216878364870322f * 1.4426950408889634f;
                const bool tail = (kt * 64 + 64) > nkeys;
                float mx = -INFINITY;
#pragma unroll
                for (int i = 0; i < 16; ++i) {
                    const int key0 = kt * 64 + (i & 3) + 8 * (i >> 2) + 4 * hf;
                    float a = s0[i] * sc, bq = s1[i] * sc;
                    if (tail) { if (key0 >= nkeys) a = -INFINITY; if (key0 + 32 >= nkeys) bq = -INFINITY; }
                    s0[i] = a; s1[i] = bq; mx = fmaxf(mx, fmaxf(a, bq));
                }
                mx = fmaxf(mx, __shfl_xor(mx, 32));
                const float m_new = fmaxf(m_run, mx);
                const float alpha = __builtin_amdgcn_exp2f(m_run - m_new);
                float ls = 0.f;
#pragma unroll
                for (int i = 0; i < 16; ++i) { s0[i] = __builtin_amdgcn_exp2f(s0[i] - m_new); s1[i] = __builtin_amdgcn_exp2f(s1[i] - m_new); ls += s0[i] + s1[i]; }
                l_run = l_run * alpha + ls; m_run = m_new;
#pragma unroll
                for (int d = 0; d < 4; ++d)
#pragma unroll
                    for (int i = 0; i < 16; ++i) o[d][i] *= alpha;
#pragma unroll
                for (int s = 0; s < 4; ++s) {
                    u32x4 pw;
                    if (s < 2) { const int e = (s & 1) * 8; pw.x = pk2(s0[e + 0], s0[e + 1]); pw.y = pk2(s0[e + 2], s0[e + 3]); pw.z = pk2(s0[e + 4], s0[e + 5]); pw.w = pk2(s0[e + 6], s0[e + 7]); }
                    else { const int e = (s & 1) * 8; pw.x = pk2(s1[e + 0], s1[e + 1]); pw.y = pk2(s1[e + 2], s1[e + 3]); pw.z = pk2(s1[e + 4], s1[e + 5]); pw.w = pk2(s1[e + 6], s1[e + 7]); }
                    const bf16x8 pf = __builtin_bit_cast(bf16x8, pw);
#pragma unroll
                    for (int d = 0; d < 4; ++d) {
                        const LAS unsigned char* va = vb + (d * 32 + r32) * AT_VROW + (s * 16 + 4 * hf) * 2;
                        const s16x4 lo = *(const LAS s16x4*)va, hi = *(const LAS s16x4*)(va + 16);
                        const bf16x8 vf = __builtin_shufflevector(lo, hi, 0, 1, 2, 3, 4, 5, 6, 7);
                        o[d] = __builtin_amdgcn_mfma_f32_32x32x16_bf16(vf, pf, o[d], 0, 0, 0);
                    }
                }
            }
            if (kt + 1 < ntiles) AT_STORE_TILE(buf ^ 1);
            __syncthreads();
        }
        if (my_tiles > 0) {
            const float l = l_run + __shfl_xor(l_run, 32);
            const float inv = 1.0f / l;
            bf16_t* orow = mix + (size_t)(qrow0 + r32) * 2048 + 1024 + h * 128;
#pragma unroll
            for (int d = 0; d < 4; ++d)
#pragma unroll
                for (int g = 0; g < 4; ++g) {
                    u32x2 wv; wv.x = pk2(o[d][4 * g + 0] * inv, o[d][4 * g + 1] * inv); wv.y = pk2(o[d][4 * g + 2] * inv, o[d][4 * g + 3] * inv);
                    *(u32x2*)(orow + d * 32 + 8 * g + 4 * hf) = wv;
                }
        }
    }
}

DI void pool_phase(const Frame& F0, const Params& p, int j) {
    const Frame F = refresh(F0);
    unsigned char* ws = p.ws;
    const float* xf = (const float*)(ws + WS_XF); bf16_t* pd = (bf16_t*)(ws + WS_MIX);
    const float* pst = p.in[9] + (size_t)j * 8 * 15 * 2048;
    const int c = F.tid * 4, grp = c >> 9, wlen = 2 << grp;
    for (int sgm = F.vcu; sgm < 264; sgm += F.G) {
        const int r0 = sgm * 32; const bool smp = r0 >= RP; const int b = smp ? ((r0 - RP) >> 5) : (r0 >> 11); const int t0 = smp ? 0 : (r0 & 2047);
        const int T = smp ? 32 : 2048;
#define POOL_FULL(tt_) (((tt_) >= 0) ? *(const f32x4*)(xf + (size_t)(r0 - t0 + (tt_)) * D + c) : (smp ? *(const f32x4*)(pst + ((size_t)b * 15 + (15 + (tt_))) * 2048 + c) : (f32x4){0.f, 0.f, 0.f, 0.f}))
        f32x4 s = (f32x4){0.f, 0.f, 0.f, 0.f};
        for (int k = 1; k < wlen; ++k) { const int tt0 = t0 - k; s += POOL_FULL(tt0); }
        for (int i = 0; i < 32; ++i) {
            const int t = t0 + i; const size_t r = (size_t)r0 + i;
            const f32x4 x = *(const f32x4*)(xf + r * D + c);
            s += x;
            const int pos = smp ? 1024 + t : t; const int cnt = (pos + 1) < wlen ? (pos + 1) : wlen;
            const f32x4 dd = s * (1.0f / (float)cnt) - x;
            u32x2 w; w.x = pk2(dd[0], dd[1]); w.y = pk2(dd[2], dd[3]); *(u32x2*)(pd + r * D + c) = w;
            { const int tt1 = t - wlen + 1; s -= POOL_FULL(tt1); }
            if (t >= T - 15) {
                float* dst = smp ? (p.out + O_SPOOL + (((size_t)j * 8 + b) * 15 + (t - (T - 15))) * 2048 + c) : (p.out + O_PPOOL + (((size_t)j * 4 + b) * 15 + (t - (T - 15))) * 2048 + c);
                *(f32x4*)dst = x;
            }
        }
    }
}

__global__ void __launch_bounds__(512, 2) mk_fwd(Params p) {
    extern __shared__ __attribute__((aligned(16))) unsigned char lds_raw[];
    Frame F;
    F.lds = (LAS unsigned char*)lds_raw;
    F.tid = threadIdx.x; F.lane = F.tid & 63; F.wave = __builtin_amdgcn_readfirstlane(F.tid >> 6);
    F.G = gridDim.x; { const int bx = blockIdx.x; F.vcu = (F.G % 8 == 0) ? (bx % 8) * (F.G / 8) + bx / 8 : bx; }
    volatile LAS unsigned* MISC = (volatile LAS unsigned*)(F.lds + MISC_OFF);
    if (F.tid < 16) MISC[F.tid] = 0u;
    __syncthreads();
    unsigned char* ws = p.ws;
    XcdBarrier bar; bar.bar = (unsigned*)(ws + WS_CTL); bar.x = 0; bar.st = MISC;
    const bool multi = (p.ph_hi - p.ph_lo) > 1;
    if (multi) bar = xcd_barrier_post((unsigned*)(ws + WS_CTL), MISC);
    bool did = false;
    const int lo = p.ph_lo, hi = p.ph_hi;
#define PHASE(id) if (lo <= (id) && (id) < hi && ((did ? (xcd_barrier(bar), 0) : 0), did = true, __builtin_amdgcn_s_waitcnt(0), true))
    LAS unsigned char* stage = F.lds + STAGE_OFF;
    const int G = F.G, vcu = F.vcu;

    bf16_t* xb = (bf16_t*)(ws + WS_XB); float* xf = (float*)(ws + WS_XF); float* tb = (float*)(ws + WS_TB);

    PHASE(0) { p0_prologue(F, p); }

    PHASE(1) {
        const bf16_t* membf = (const bf16_t*)(ws + WS_MEMBF);
        { DecMemKV dc{(unsigned)WS_MEMBF, (unsigned)WS_WK, (unsigned)WS_WV};
          EpiF32<F_MEMKV> ep{p.out, 2048, nullptr, nullptr, (bf16_t*)(ws + WS_MEMK), 2048};
          gemm_phase(F.wave, (const char*)ws, stage, 2048, 2048, 2048, first_of(vcu, G, 0), G, 256, dc, ep); }
        { DecMemVT dc{(unsigned)WS_WV, (unsigned)WS_MEMBF};
          EpiBF<BF_PLAIN> ep{(bf16_t*)(ws + WS_MEMVT), 256, nullptr, nullptr, nullptr, nullptr, 0.f};
          gemm_phase(F.wave, (const char*)ws, stage, 2048, 2048, 2048, first_of(vcu, G, 256), G, 128, dc, ep); }
    }

    for (int l = 0; l < 4; ++l) {
        const int j = l >> 1, base = 2 + 14 * l;
        const float* lng = p.in[32] + (size_t)l * 3 * D; const float* lnb = p.in[33] + (size_t)l * 3 * D;
        if ((l & 1) == 0) {
            PHASE(base + 0) {
                DecDense dc{(unsigned)WS_XB, (unsigned)(WS_WIN + (size_t)(j * INP * 2048) * 2), 2048, 2048, INP, 33, 12, 1 << 20, 0};
                EpiBF<BF_PLAIN> ep{(bf16_t*)(ws + WS_ZB), INP, nullptr, nullptr, nullptr, nullptr, 0.f};
                gemm_phase(F.wave, (const char*)ws, stage, 2048, 2048, 2048, first_of(vcu, G, 0), G, 33 * 12, dc, ep);
            }
            PHASE(base + 1) { e2_phase(F, p, j); }
            PHASE(base + 2) {
                int off = 0;
                {
                    DecDense dc{(unsigned)WS_UCB, (unsigned)(WS_WGT + (size_t)(j * 2048 * 256) * 2), 1024, 256, 2048, 33, 8, 2, 256};
                    EpiBF<BF_SIGMOID> ep{(bf16_t*)(ws + WS_GAT), 2048, (const float*)(ws + WS_CTL + 32768) + (size_t)j * 2048, nullptr, nullptr, nullptr, 0.f};
                    gemm_phase(F.wave, (const char*)ws, stage, 256, 1024, 256, first_of(vcu, G, off), G, 33 * 8, dc, ep); off += 33 * 8;
                }
                {
                    DecDense dc{(unsigned)WS_CQN, (unsigned)(WS_WUQ + (size_t)(j * 1536 * 512) * 2), 512, 512, 1536, 33, 6, 1 << 20, 0};
                    EpiBF<BF_ROPE> ep{(bf16_t*)(ws + WS_Q), 1536, nullptr, (const float*)(ws + WS_ROPE), (const float*)(ws + WS_ROPE) + 2048 * 32, nullptr, 0.f};
                    gemm_phase(F.wave, (const char*)ws, stage, 512, 512, 512, first_of(vcu, G, off), G, 33 * 6, dc, ep); off += 33 * 6;
                }
                {
                    DecDense dc{(unsigned)(WS_CKV + (size_t)(j * KEYSPAD * 256) * 2), (unsigned)(WS_WUK + (size_t)(j * 1024 * 256) * 2), 256, 256, 1024, 65, 4, 1 << 20, 0};
                    EpiBF<BF_PLAIN> ep{(bf16_t*)(ws + WS_KN), 1024, nullptr, nullptr, nullptr, nullptr, 0.f};
                    gemm_phase(F.wave, (const char*)ws, stage, 256, 256, 256, first_of(vcu, G, off), G, 65 * 4, dc, ep); off += 65 * 4;
                }
                {
                    DecDense dc{(unsigned)(WS_WUV + (size_t)(j * 1024 * 256) * 2), (unsigned)(WS_CKV + (size_t)(j * KEYSPAD * 256) * 2), 256, 256, KEYS, 4, 65, 1 << 20, 0};
                    EpiBF<BF_PLAIN> ep{(bf16_t*)(ws + WS_VT), KEYS, nullptr, nullptr, nullptr, nullptr, 0.f};
                    gemm_phase(F.wave, (const char*)ws, stage, 256, 256, 256, first_of(vcu, G, off), G, 4 * 65, dc, ep); off += 4 * 65;
                }
            }
            PHASE(base + 3) { scan_phase(F, p, j); __syncthreads(); attn_phase(F, p, j); }
            PHASE(base + 4) {
                DecDense dc{(unsigned)WS_MIX, (unsigned)(WS_WOUT + (size_t)(j * 2048 * 2048) * 2), 2048, 2048, 2048, 33, 8, 1 << 20, 0};
                EpiF32<F_RESID> ep{tb, 2048, xf, nullptr, nullptr, 0};
                gemm_phase(F.wave, (const char*)ws, stage, 2048, 2048, 2048, first_of(vcu, G, 0), G, 33 * 8, dc, ep);
            }
            PHASE(base + 5) { ln_phase(F, tb, lng, lnb, xf, xb); }
        } else {
            PHASE(base + 0) { pool_phase(F, p, j); }
            PHASE(base + 1) {
                DecDense dc{(unsigned)WS_MIX, (unsigned)(WS_WPOOL + (size_t)(j * 2048 * 512) * 2), 2048, 512, 2048, 33, 8, 2, 512};
                EpiF32<F_RESID> ep{tb, 2048, xf, p.in[25] + (size_t)j * 2048, nullptr, 0};
                gemm_phase(F.wave, (const char*)ws, stage, 512, 2048, 512, first_of(vcu, G, 0), G, 33 * 8, dc, ep);
            }
            PHASE(base + 2) { ln_phase(F, tb, lng, lnb, xf, xb); }
        }
        PHASE(base + 6) {
            DecDense dc{(unsigned)WS_XB, (unsigned)(WS_WQ + (size_t)(l * 2048 * 2048) * 2), 2048, 2048, 2048, 33, 8, 1 << 20, 0};
            EpiBF<BF_PLAIN> ep{(bf16_t*)(ws + WS_QX), 2048, nullptr, nullptr, nullptr, nullptr, 0.f};
            gemm_phase(F.wave, (const char*)ws, stage, 2048, 2048, 2048, first_of(vcu, G, 0), G, 33 * 8, dc, ep);
        }
        PHASE(base + 7) {
            DecXS dc{(unsigned)WS_QX, (unsigned)(WS_MEMK + (size_t)(l * 12 * 256 * 2048) * 2)};
            EpiBF<BF_EXP> ep{(bf16_t*)(ws + WS_E), 1024, nullptr, nullptr, nullptr, (float*)(ws + WS_RS4), 0.044194173824159216f};
            gemm_phase(F.wave, (const char*)ws, stage, 512, 2048, 2048, first_of(vcu, G, 0), G, 160, dc, ep);
        }
        PHASE(base + 8) {
            DecXPV dc{(unsigned)WS_E, (unsigned)(WS_MEMVT + (size_t)(l * 12 * 2048 * 256) * 2)};
            EpiBF<BF_DIV> ep{(bf16_t*)(ws + WS_OX), 2048, nullptr, nullptr, nullptr, (float*)(ws + WS_RS4), 0.f};
            gemm_phase(F.wave, (const char*)ws, stage, 256, 1024, 256, first_of(vcu, G, 0), G, 320, dc, ep);
        }
        PHASE(base + 9) {
            DecDense dc{(unsigned)WS_OX, (unsigned)(WS_WO + (size_t)(l * 2048 * 2048) * 2), 2048, 2048, 2048, 33, 8, 1 << 20, 0};
            EpiF32<F_RESID> ep{tb, 2048, xf, nullptr, nullptr, 0};
            gemm_phase(F.wave, (const char*)ws, stage, 2048, 2048, 2048, first_of(vcu, G, 0), G, 33 * 8, dc, ep);
        }
        PHASE(base + 10) { ln_phase(F, tb, lng + D, lnb + D, xf, xb); }
        PHASE(base + 11) {
            DecDense dc{(unsigned)WS_XB, (unsigned)(WS_WUP + (size_t)(l * 8192 * 2048) * 2), 2048, 2048, DFF, 33, 32, 1 << 20, 0};
            EpiBF<BF_RELU2> ep{(bf16_t*)(ws + WS_HB), DFF, nullptr, nullptr, nullptr, nullptr, 0.f};
            gemm_phase(F.wave, (const char*)ws, stage, 2048, 2048, 2048, first_of(vcu, G, 0), G, 33 * 32, dc, ep);
        }
        PHASE(base + 12) {
            DecDense dc{(unsigned)WS_HB, (unsigned)(WS_WDN + (size_t)(l * 2048 * 8192) * 2), DFF, DFF, 2048, 33, 8, 1 << 20, 0};
            EpiF32<F_RESID> ep{tb, 2048, xf, nullptr, nullptr, 0};
            gemm_phase(F.wave, (const char*)ws, stage, DFF, DFF, DFF, first_of(vcu, G, 0), G, 33 * 8, dc, ep);
        }
        PHASE(base + 13) { ln_phase(F, tb, lng + 2 * D, lnb + 2 * D, (l == 3) ? (p.out + O_Y) : xf, xb); }
    }
#undef PHASE
}

extern "C" void kernel_launch(void* const* d_in, const int* in_sizes, int n_in, void* d_out, int out_size, void* d_ws, size_t ws_size, hipStream_t stream) {
    static int grid = 0;
    if (grid == 0) {
        if (n_in != 34 || (size_t)out_size != O_END || ws_size < WS_END) {
            fprintf(stderr, "kernel_launch: expected 34 inputs, %zu outputs, >= %zu bytes of workspace; got %d, %d, %zu; nothing launched\n", (size_t)O_END, (size_t)WS_END, n_in, out_size, ws_size);
            grid = -1; return; }
        int dev = 0, cus = 0, per_cu = 0;
        if (hipGetDevice(&dev) != hipSuccess || hipDeviceGetAttribute(&cus, hipDeviceAttributeMultiprocessorCount, dev) != hipSuccess) { grid = -1; return; }
        if (hipFuncSetAttribute((const void*)mk_fwd, hipFuncAttributeMaxDynamicSharedMemorySize, LDS_BYTES) != hipSuccess) { fprintf(stderr, "kernel_launch: hipFuncSetAttribute failed\n"); grid = -1; return; }
        if (hipOccupancyMaxActiveBlocksPerMultiprocessor(&per_cu, (const void*)mk_fwd, 512, LDS_BYTES) != hipSuccess || per_cu < 1) {
            fprintf(stderr, "kernel_launch: occupancy query reports %d workgroups per CU\n", per_cu); }
        (void)hipGetLastError();
        grid = cus;
    }
    if (grid < 0) return;
    if (hipMemsetAsync((char*)d_ws + WS_CTL, 0, 32768, stream) != hipSuccess) { fprintf(stderr, "kernel_launch: memset failed\n"); return; }
    Params p{};
    for (int i = 0; i < 34; ++i) p.in[i] = (const float*)d_in[i];
    p.out = (float*)d_out; p.ws = (unsigned char*)d_ws;
#if MK_LAUNCHES == 1
    p.ph_lo = 0; p.ph_hi = NPH;
    hipLaunchKernelGGL(mk_fwd, dim3(grid), dim3(512), LDS_BYTES, stream, p);
#else
    for (int ph = 0; ph < NPH; ++ph) { p.ph_lo = ph; p.ph_hi = ph + 1; hipLaunchKernelGGL(mk_fwd, dim3(grid), dim3(512), LDS_BYTES, stream, p); }
#endif
    const hipError_t le = hipPeekAtLastError();
    if (le != hipSuccess) fprintf(stderr, "kernel_launch: launch failed: %s\n", hipGetErrorName(le));
}
```

```cpp
#include <hip/hip_runtime.h>
#include <cstdio>
#include <cstdint>

#ifndef PROBE_DUP
#define PROBE_DUP 0
#endif
#define DUP(g) for (int rep_ = 0; rep_ < (((PROBE_DUP) >> (g)) & 1) + 1; ++rep_)
#ifndef MK_LAUNCHES
#define MK_LAUNCHES 1
#endif

#define LAS __attribute__((address_space(3)))
#define DI __device__ __forceinline__
typedef unsigned short bf16_t;
typedef short bf16x8 __attribute__((ext_vector_type(8)));
typedef short s16x4 __attribute__((ext_vector_type(4)));
typedef float f32x4 __attribute__((ext_vector_type(4)));
typedef float f32x16 __attribute__((ext_vector_type(16)));
typedef unsigned u32x4 __attribute__((ext_vector_type(4)));
typedef unsigned u32x2 __attribute__((ext_vector_type(2)));
typedef __bf16 bf2_t __attribute__((ext_vector_type(2)));
typedef float f2_t __attribute__((ext_vector_type(2)));

DI int lane_id_asm() { int l; asm volatile("v_mbcnt_lo_u32_b32 %0, -1, 0\n\tv_mbcnt_hi_u32_b32 %0, -1, %0" : "=v"(l)); return l; }
DI unsigned pk2(float lo, float hi) { f2_t v = {lo, hi}; return __builtin_bit_cast(unsigned, __builtin_convertvector(v, bf2_t)); }
DI float bflo(unsigned w) { return __uint_as_float(w << 16); }
DI float bfhi(unsigned w) { return __uint_as_float(w & 0xffff0000u); }
DI float bf2f(bf16_t b) { return __uint_as_float(((unsigned)b) << 16); }

#define XB_TMO      128
#define XB_XCNT(j)  (256  + 64 * (j))
#define XB_XSUB(j)  (1280 + 64 * (j))
#define XB_XGEN(j)  (2304 + 64 * (j))
#define XB_TOP      3328
#define XB_TOPGEN   3392
#define XCD_BAR_WORDS 3456
#define XB_SPIN_CAP (1u << 18)

__device__ __forceinline__ unsigned xb_ld(unsigned* p)              { return __hip_atomic_load(p, __ATOMIC_RELAXED, __HIP_MEMORY_SCOPE_AGENT); }
__device__ __forceinline__ unsigned xb_add(unsigned* p, unsigned v) { return __hip_atomic_fetch_add(p, v, __ATOMIC_RELAXED, __HIP_MEMORY_SCOPE_AGENT); }
__device__ __forceinline__ unsigned xb_xcc_id() { return (unsigned)__builtin_amdgcn_s_getreg((3 << 11) | 20) & 0xFu; }
#define XB_SPIN(cond, bar) do { unsigned _sp = 0; while (cond) { __builtin_amdgcn_s_sleep(1); \
    if ((++_sp & 255u) == 0u) { if (xb_ld(&(bar)[XB_TMO])) break; if (_sp > XB_SPIN_CAP) { atomicAdd(&(bar)[XB_TMO], 1u); break; } } } } while (0)

struct XcdBarrier {
    unsigned* bar; unsigned x;
    volatile LAS unsigned* st;
};
__device__ __forceinline__ XcdBarrier xcd_barrier_post(unsigned* bar, volatile LAS unsigned* st) {
    XcdBarrier b; b.bar = bar; b.x = xb_xcc_id(); b.st = st;
    if (threadIdx.x == 0) (void)xb_add(&bar[XB_XCNT(b.x)], 1u);
    return b;
}
__device__ __forceinline__ void xcd_barrier_complete(unsigned* bar, unsigned x, unsigned& nloc, unsigned& nx) {
    const unsigned G = gridDim.x * gridDim.y * gridDim.z;
    unsigned sum, cnt, mine, sp = 0u;
    for (;;) {
        sum = 0u; cnt = 0u; mine = 0u;
#pragma unroll
        for (unsigned j = 0; j < 16; ++j) { const unsigned c = xb_ld(&bar[XB_XCNT(j)]); sum += c; cnt += (c > 0u) ? 1u : 0u; mine = (j == x) ? c : mine; }
        if (sum == G) break;
        __builtin_amdgcn_s_sleep(1);
        if ((++sp & 255u) == 0u) { if (xb_ld(&bar[XB_TMO])) break; if (sp > XB_SPIN_CAP) { atomicAdd(&bar[XB_TMO], 1u); break; } }
    }
    nloc = mine > 0u ? mine : 1u; nx = cnt > 0u ? cnt : 1u;
}
__device__ __forceinline__ void xcd_barrier(const XcdBarrier& b) {
    asm volatile("s_waitcnt vmcnt(0)" ::: "memory");
    __syncthreads();
    if (threadIdx.x == 0) {
        unsigned* bar = b.bar;
        __builtin_amdgcn_s_waitcnt(0);
        unsigned nloc = b.st[0], nx = b.st[1];
        if (nloc == 0u) { xcd_barrier_complete(bar, b.x, nloc, nx); b.st[0] = nloc; b.st[1] = nx; }
        const unsigned old = xb_add(&bar[XB_XSUB(b.x)], 1u);
        const unsigned gen = old / nloc;
        if (old + 1u == (gen + 1u) * nloc) {
            __builtin_amdgcn_fence(__ATOMIC_RELEASE, "agent");
            asm volatile("s_waitcnt vmcnt(0)" ::: "memory");
            const unsigned og = xb_add(&bar[XB_TOP], 1u);
            const unsigned tg = og / nx;
            if (og + 1u == (tg + 1u) * nx) xb_add(&bar[XB_TOPGEN], 1u);
            else XB_SPIN(xb_ld(&bar[XB_TOPGEN]) == tg, bar);
            __builtin_amdgcn_fence(__ATOMIC_ACQUIRE, "agent");
            xb_add(&bar[XB_XGEN(b.x)], 1u);
            asm volatile("s_waitcnt vmcnt(0)" ::: "memory");
        } else {
            XB_SPIN(xb_ld(&bar[XB_XGEN(b.x)]) == gen, bar);
            __builtin_amdgcn_fence(__ATOMIC_ACQUIRE, "agent");
            asm volatile("s_waitcnt vmcnt(0)" ::: "memory");
        }
    }
    __syncthreads();
}

constexpr int D = 2048, RP = 8192, RS = 256, R = RP + RS, RPAD = R + 256;
constexpr int INC = 2880, INP = 3072;
constexpr int KEYS = 16640, KEYSPAD = KEYS + 64;
constexpr int DFF = 8192;
constexpr float DN_ALPHA = 1.681792830507429f;
constexpr float LN_EPS = 1e-5f, RMS_EPS = 1e-6f;
constexpr int NPH = 2 + 14 * 4;
constexpr int LDS_BYTES = 147456;
constexpr int STAGE_OFF = 0, MISC_OFF = 131072;

constexpr size_t O_Y = 0;
constexpr size_t O_PCONV = 17301504, O_PH = 17326080, O_PCKV = 17334272, O_PKPE = 21528576, O_PPOOL = 22577152;
constexpr size_t O_PMEMK = 22822912, O_PMEMV = 31211520, O_SCONV = 39600128, O_SH = 39649280, O_SCKV = 39665664, O_SKPE = 39796736, O_SPOOL = 39829504;
constexpr size_t O_END = 40321024;

constexpr size_t al(size_t x) { return (x + 255) & ~(size_t)255; }
constexpr size_t WS_CTL = 0;
constexpr size_t CTL_BYTES = 65536;
constexpr size_t WS_ROPE = WS_CTL + CTL_BYTES;
constexpr size_t WS_WIN = WS_ROPE + 2 * 2048 * 32 * 4;
constexpr size_t WS_WUQ = WS_WIN + (size_t)2 * INP * 2048 * 2;
constexpr size_t WS_WUK = WS_WUQ + (size_t)2 * 1536 * 512 * 2;
constexpr size_t WS_WUV = WS_WUK + (size_t)2 * 1024 * 256 * 2;
constexpr size_t WS_WGT = WS_WUV + (size_t)2 * 1024 * 256 * 2;
constexpr size_t WS_WOUT = WS_WGT + (size_t)2 * 2048 * 256 * 2;
constexpr size_t WS_WPOOL = WS_WOUT + (size_t)2 * 2048 * 2048 * 2;
constexpr size_t WS_WQ = WS_WPOOL + (size_t)2 * 2048 * 512 * 2;
constexpr size_t WS_WK = WS_WQ + (size_t)4 * 2048 * 2048 * 2;
constexpr size_t WS_WV = WS_WK + (size_t)4 * 2048 * 2048 * 2;
constexpr size_t WS_WO = WS_WV + (size_t)4 * 2048 * 2048 * 2;
constexpr size_t WS_WUP = WS_WO + (size_t)4 * 2048 * 2048 * 2;
constexpr size_t WS_WDN = WS_WUP + (size_t)4 * 8192 * 2048 * 2;
constexpr size_t WS_XF = WS_WDN + (size_t)4 * 8192 * 2048 * 2;
constexpr size_t WS_XB = WS_XF + (size_t)R * D * 4;
constexpr size_t WS_TB = WS_XB + (size_t)RPAD * D * 2;
constexpr size_t WS_MEMK = WS_TB + (size_t)R * D * 4;
constexpr size_t WS_MEMVT = WS_MEMK + (size_t)4 * 12 * 256 * 2048 * 2;
constexpr size_t WS_CKV = WS_MEMVT + (size_t)4 * 12 * 256 * 2048 * 2;
constexpr size_t WS_KPE = WS_CKV + (size_t)2 * KEYSPAD * 256 * 2;
constexpr size_t WS_MEMBF = WS_KPE + (size_t)2 * KEYSPAD * 64 * 2;
constexpr size_t WS_SCR = al(WS_MEMBF + (size_t)1024 * 2048 * 2);
constexpr size_t WS_ZB = WS_SCR;
constexpr size_t WS_UCB = WS_ZB + (size_t)R * INP * 2;
constexpr size_t WS_CQN = WS_UCB + (size_t)RPAD * 1024 * 2;
constexpr size_t WS_GAT = WS_CQN + (size_t)RPAD * 512 * 2;
constexpr size_t WS_Q = WS_GAT + (size_t)R * 2048 * 2;
constexpr size_t WS_KN = WS_Q + (size_t)RPAD * 1536 * 2;
constexpr size_t WS_VT = WS_KN + (size_t)KEYSPAD * 1024 * 2;
constexpr size_t WS_MIX = al(WS_VT + (size_t)1024 * KEYS * 2 + 4096);
constexpr size_t WS_SCR_END1 = WS_MIX + (size_t)RPAD * 2048 * 2;
constexpr size_t WS_QX = WS_SCR;
constexpr size_t WS_E = WS_QX + (size_t)RPAD * 2048 * 2;
constexpr size_t WS_RS4 = WS_E + (size_t)RPAD * 1024 * 2;
constexpr size_t WS_OX = WS_RS4 + (size_t)R * 16 * 4;
constexpr size_t WS_SCR_END2 = WS_OX + (size_t)RPAD * 2048 * 2;
static_assert(WS_SCR_END2 <= WS_Q, "cross scratch must stay inside the dead mixer buffers");
constexpr size_t WS_HB = WS_SCR;
constexpr size_t WS_SCR_END3 = WS_HB + (size_t)RPAD * DFF * 2;
constexpr size_t WS_SLAB = al((WS_SCR_END1 > WS_SCR_END3 ? WS_SCR_END1 : WS_SCR_END3) + 4096);
constexpr size_t WS_END = WS_SLAB + (size_t)32 * 256 * 2048 * 4 + 4096;
static_assert(WS_END < (1ull << 32), "GEMM operand offsets are 32-bit");

struct Params {
    const float* in[34];
    float* out;
    unsigned char* ws;
    int ph_lo, ph_hi;
};

constexpr int HTB = 128 * 64 * 2;
DI int lds_byte(int r, int c) { const int st = (r >> 4) * 2 + (c >> 5), rr = r & 15, cc = c & 31, ob = rr * 64 + cc * 2; return st * 1024 + (ob ^ (((ob >> 9) & 1) << 5)); }
DI void stage_rc(int b, int& Rr, int& C) { const int st = b / 1024, sb = b % 1024, swz = sb ^ (((sb >> 9) & 1) << 5); Rr = (st >> 1) * 16 + swz / 64; C = (st & 1) * 32 + (swz % 64) / 2; }
DI int perm32(int rho) { const int n = rho >> 4, i = rho & 15; return 8 * (i >> 2) + 4 * n + (i & 3); }

struct GUnit { unsigned A, B; long ooff; long ooff2; int r0, c0, nvalid, aux, nt, kind; };

template <class Epi, class Dec>
DI void gemm_phase(const int wave_id, const char* wsb, LAS unsigned char* lds, const int lda, const int ldb, const int first, const int stride, const int count, const Dec& Dc, const Epi& E) {
    const int lane = lane_id_asm(), wid = wave_id, tid = wid * 64 + lane,
               wr = wid >> 2, wc = wid & 3, fr = lane & 15, fq = lane >> 4;
    __builtin_amdgcn_s_waitcnt(0);
    if (first >= count) return;
    unsigned voffA[2], voffB[2];
#pragma unroll
    for (int i = 0; i < 2; ++i) { int Rr, C; stage_rc(tid * 16 + i * 8192, Rr, C); const int Rb = Epi::PERM ? ((Rr & ~31) + perm32(Rr & 31)) : Rr;
        voffA[i] = (unsigned)(Rr * lda + C) * 2u; voffB[i] = (unsigned)(Rb * ldb + C) * 2u; }
    const unsigned kstep = 128u;
    const unsigned hstepA = 128u * (unsigned)lda * 2u, hstepB = 128u * (unsigned)ldb * 2u;
    const unsigned ldsw = (unsigned)wid * 1024u;
    const int aoff = lds_byte(wr * 64 + fr, fq * 8), boff = lds_byte(wc * 32 + fr, fq * 8);
#define PG8_SA(b, h) (((b) * 2 + (h)) * HTB)
#define PG8_SB(b, h) ((4 + (b) * 2 + (h)) * HTB)
#define PG8_STAGE(bufoff, gbase, voff) do { _Pragma("unroll") for (int _i = 0; _i < 2; ++_i) \
        __builtin_amdgcn_global_load_lds((const unsigned*)(wsb + (size_t)(unsigned)((gbase) + (voff)[_i])), (LAS unsigned*)(lds + (bufoff) + ldsw + _i * 8192), 16, 0, 0); } while (0)
#define PG8_LDA(dst, b, h) do { _Pragma("unroll") for (int m = 0; m < 4; ++m) _Pragma("unroll") for (int k = 0; k < 2; ++k) dst[m][k] = *(const LAS bf16x8*)(lds + PG8_SA(b, h) + aoff + m * 2048 + k * 1024); } while (0)
#define PG8_LDB(dst, b, h) do { _Pragma("unroll") for (int n = 0; n < 2; ++n) _Pragma("unroll") for (int k = 0; k < 2; ++k) dst[n][k] = *(const LAS bf16x8*)(lds + PG8_SB(b, h) + boff + n * 2048 + k * 1024); } while (0)
#define PG8_MMA(ai, bj, At, Bt) do { __builtin_amdgcn_s_setprio(1); _Pragma("unroll") for (int m = 0; m < 4; ++m) _Pragma("unroll") for (int n = 0; n < 2; ++n) _Pragma("unroll") for (int k = 0; k < 2; ++k) \
        acc[ai][bj][m][n] = __builtin_amdgcn_mfma_f32_16x16x32_bf16(Bt[n][k], At[m][k], acc[ai][bj][m][n], 0, 0, 0); __builtin_amdgcn_s_setprio(0); } while (0)
#define PG8_WAIT_V(n) asm volatile("s_waitcnt vmcnt(" #n ")" ::: "memory")
#define PG8_WAIT_L(n) asm volatile("s_waitcnt lgkmcnt(" #n ")" ::: "memory")
#define PG8_BAR __builtin_amdgcn_s_barrier()
#define PG8_SCHED __builtin_amdgcn_sched_barrier(0)
    int L = first;
    unsigned cA, cB; int nt;
    { GUnit u0; Dc(L, u0); cA = u0.A; cB = u0.B; nt = u0.nt; }
    f32x4 acc[2][2][4][2];
#pragma unroll
    for (int a = 0; a < 2; ++a)
#pragma unroll
        for (int b = 0; b < 2; ++b)
#pragma unroll
            for (int m = 0; m < 4; ++m)
#pragma unroll
                for (int n = 0; n < 2; ++n) acc[a][b][m][n] = (f32x4){0.f, 0.f, 0.f, 0.f};
    bf16x8 At[4][2], B0[2][2], B1[2][2];
    PG8_STAGE(PG8_SB(0, 0), cB, voffB); PG8_STAGE(PG8_SB(0, 1), cB + hstepB, voffB); PG8_STAGE(PG8_SA(0, 0), cA, voffA); PG8_STAGE(PG8_SA(0, 1), cA + hstepA, voffA);
    if (wr == 1) PG8_BAR;
    PG8_WAIT_V(2); PG8_BAR;
    PG8_STAGE(PG8_SB(1, 0), cB + kstep, voffB); PG8_STAGE(PG8_SA(1, 0), cA + kstep, voffA); PG8_STAGE(PG8_SB(1, 1), cB + hstepB + kstep, voffB);
    PG8_WAIT_V(6); PG8_BAR;
    for (;;) {
        const bool has_next = (L + stride) < count;
        unsigned nA = cA, nB = cB; int nnt = nt;
        if (has_next) { GUnit un; Dc(L + stride, un); nA = un.A; nB = un.B; nnt = un.nt; }
        for (int t = 0; t < nt; t += 2) {
            const bool last = (t == nt - 2);
            const unsigned a1 = cA + (unsigned)(t + 1) * kstep;
            const unsigned a2 = last ? nA : cA + (unsigned)(t + 2) * kstep; const unsigned b2 = last ? nB : cB + (unsigned)(t + 2) * kstep;
            const unsigned a3 = a2 + kstep, b3 = b2 + kstep;
            PG8_LDB(B0, 0, 0); PG8_LDB(B1, 0, 1); PG8_SCHED; PG8_LDA(At, 0, 0); PG8_STAGE(PG8_SA(1, 1), a1 + hstepA, voffA);
            PG8_WAIT_V(8); PG8_WAIT_L(0); PG8_BAR; PG8_MMA(0, 0, At, B0); PG8_MMA(0, 1, At, B1); PG8_BAR; PG8_SCHED;
            PG8_LDA(At, 0, 1); PG8_STAGE(PG8_SB(0, 0), b2, voffB); PG8_STAGE(PG8_SB(0, 1), b2 + hstepB, voffB); PG8_STAGE(PG8_SA(0, 0), a2, voffA);
            PG8_WAIT_V(8); PG8_WAIT_L(0); PG8_BAR; PG8_MMA(1, 0, At, B0); PG8_MMA(1, 1, At, B1); PG8_BAR; PG8_SCHED;
            PG8_LDB(B0, 1, 0); PG8_LDB(B1, 1, 1); PG8_SCHED; PG8_LDA(At, 1, 0); PG8_STAGE(PG8_SA(0, 1), a2 + hstepA, voffA);
            PG8_WAIT_V(8); PG8_WAIT_L(0); PG8_BAR; PG8_MMA(0, 0, At, B0); PG8_MMA(0, 1, At, B1); PG8_BAR; PG8_SCHED;
            PG8_LDA(At, 1, 1); PG8_STAGE(PG8_SB(1, 0), b3, voffB); PG8_STAGE(PG8_SB(1, 1), b3 + hstepB, voffB); PG8_STAGE(PG8_SA(1, 0), a3, voffA);
            PG8_WAIT_V(8); PG8_WAIT_L(0); PG8_BAR; PG8_MMA(1, 0, At, B0); PG8_MMA(1, 1, At, B1); PG8_BAR; PG8_SCHED;
        }
        if (wr == 0) PG8_BAR;
        { GUnit uc; Dc(L, uc); int fr2 = fr, fq2 = fq; asm volatile("" : "+v"(fr2), "+v"(fq2)); E(acc, uc, wr, wc, fr2, fq2); }
        if (!has_next) break;
#pragma unroll
        for (int a = 0; a < 2; ++a)
#pragma unroll
            for (int b = 0; b < 2; ++b)
#pragma unroll
                for (int m = 0; m < 4; ++m)
#pragma unroll
                    for (int n = 0; n < 2; ++n) acc[a][b][m][n] = (f32x4){0.f, 0.f, 0.f, 0.f};
        cA = nA; cB = nB; nt = nnt; L += stride;
        if (wr == 1) PG8_BAR;
    }
    PG8_WAIT_V(0);
    PG8_BAR;
#undef PG8_SA
#undef PG8_SB
#undef PG8_STAGE
#undef PG8_LDA
#undef PG8_LDB
#undef PG8_MMA
#undef PG8_WAIT_V
#undef PG8_WAIT_L
#undef PG8_BAR
#undef PG8_SCHED
}

enum { BF_PLAIN = 0, BF_SIGMOID = 1, BF_ROPE = 2, BF_EXP = 3, BF_DIV = 4, BF_RELU2 = 5 };
template <int MODE> struct EpiBF {
    static constexpr bool PERM = true;
    bf16_t* O; int ldc;
    const float* bias;
    const float* rcos; const float* rsin;
    float* rs4;
    float scale;
    float* slab;
    DI void operator()(const f32x4 (&acc)[2][2][4][2], const GUnit& u, int wr, int wc, int fr, int fq) const {
        if (u.kind) {
#pragma unroll
            for (int ai = 0; ai < 2; ++ai)
#pragma unroll
                for (int m = 0; m < 4; ++m) {
                    const int r = ai * 128 + wr * 64 + m * 16 + fr;
#pragma unroll
                    for (int bj = 0; bj < 2; ++bj) { const int c = bj * 128 + wc * 32 + fq * 8; float* dst = slab + u.ooff + (size_t)r * ldc + c;
                        *(f32x4*)dst = acc[ai][bj][m][0]; *(f32x4*)(dst + 4) = acc[ai][bj][m][1]; }
                    asm volatile("" ::: "memory");
                }
            return;
        }
#pragma unroll
        for (int ai = 0; ai < 2; ++ai)
#pragma unroll
            for (int m = 0; m < 4; ++m) {
                const int r = ai * 128 + wr * 64 + m * 16 + fr;
                const bool ok = r < u.nvalid;
                float rsum = 0.f, inv = 1.f; int pos = 0;
                if (MODE == BF_DIV) { const f32x4 p = *(const f32x4*)(rs4 + ((size_t)(u.r0 + r) * 4 + u.aux) * 4); inv = 1.0f / ((p[0] + p[1]) + (p[2] + p[3])); }
                if (MODE == BF_ROPE) { const int gr = u.r0 + r; pos = gr < RP ? (gr & 2047) : 1024 + ((gr - RP) & 31); }
#pragma unroll
                for (int bj = 0; bj < 2; ++bj) {
                    const int c = bj * 128 + wc * 32 + fq * 8;
                    f32x4 v0 = acc[ai][bj][m][0], v1 = acc[ai][bj][m][1];
                    if (MODE == BF_SIGMOID) {
                        const f32x4 b0 = *(const f32x4*)(bias + u.c0 + c), b1 = *(const f32x4*)(bias + u.c0 + c + 4);
#pragma unroll
                        for (int j = 0; j < 4; ++j) { v0[j] = 1.0f / (1.0f + __expf(-(v0[j] + b0[j]))); v1[j] = 1.0f / (1.0f + __expf(-(v1[j] + b1[j]))); }
                    }
                    if (MODE == BF_ROPE) {
                        const int dd = (u.c0 + c) % 192;
                        if (dd >= 128) {
                            const int i0 = (dd - 128) >> 1;
                            const f32x4 cs = *(const f32x4*)(rcos + pos * 32 + i0), sn = *(const f32x4*)(rsin + pos * 32 + i0);
                            const float a0 = v0[0] * cs[0] - v0[1] * sn[0], a1 = v0[0] * sn[0] + v0[1] * cs[0];
                            const float a2 = v0[2] * cs[1] - v0[3] * sn[1], a3 = v0[2] * sn[1] + v0[3] * cs[1];
                            const float b0 = v1[0] * cs[2] - v1[1] * sn[2], b1 = v1[0] * sn[2] + v1[1] * cs[2];
                            const float b2 = v1[2] * cs[3] - v1[3] * sn[3], b3 = v1[2] * sn[3] + v1[3] * cs[3];
                            v0 = (f32x4){a0, a1, a2, a3}; v1 = (f32x4){b0, b1, b2, b3};
                        }
                    }
                    if (MODE == BF_EXP) {
#pragma unroll
                        for (int j = 0; j < 4; ++j) { v0[j] = __expf(v0[j] * scale); v1[j] = __expf(v1[j] * scale); }
                        rsum += ((v0[0] + v0[1]) + (v0[2] + v0[3])) + ((v1[0] + v1[1]) + (v1[2] + v1[3]));
                    }
                    if (MODE == BF_DIV) { v0 *= inv; v1 *= inv; }
                    if (MODE == BF_RELU2) {
#pragma unroll
                        for (int j = 0; j < 4; ++j) { const float a = fmaxf(v0[j], 0.f), b = fmaxf(v1[j], 0.f); v0[j] = a * a; v1[j] = b * b; }
                    }
                    u32x4 w; w.x = pk2(v0[0], v0[1]); w.y = pk2(v0[2], v0[3]); w.z = pk2(v1[0], v1[1]); w.w = pk2(v1[2], v1[3]);
                    if (ok) *(u32x4*)(O + u.ooff + (size_t)r * ldc + c) = w;
                }
                if (MODE == BF_EXP) {
                    rsum += __shfl_xor(rsum, 16); rsum += __shfl_xor(rsum, 32);
                    if (fq == 0 && ok) rs4[((size_t)(u.r0 + r) * 4 + u.aux) * 4 + wc] = rsum;
                }
                asm volatile("" ::: "memory");
            }
    }
};
enum { F_RESID = 0, F_MEMKV = 1 };
template <int MODE> struct EpiF32 {
    static constexpr bool PERM = false;
    float* O; int ldc;
    const float* X;
    const float* scale;
    bf16_t* O2; int ldc2;
    float* slab;
    DI void operator()(const f32x4 (&acc)[2][2][4][2], const GUnit& u, int wr, int wc, int fr, int fq) const {
#pragma unroll
        for (int ai = 0; ai < 2; ++ai)
#pragma unroll
            for (int m = 0; m < 4; ++m) {
                const int r = ai * 128 + wr * 64 + m * 16 + fr;
#pragma unroll
                for (int bj = 0; bj < 2; ++bj)
#pragma unroll
                    for (int n = 0; n < 2; ++n) {
                        const int c = bj * 128 + wc * 32 + n * 16 + fq * 4;
                        const size_t off = (size_t)u.ooff + (size_t)r * ldc + c;
                        f32x4 v = acc[ai][bj][m][n];
                        if (MODE == F_RESID) {
                            if (scale) v *= *(const f32x4*)(scale + u.c0 + c);
                            if (u.kind) { *(f32x4*)(slab + off) = v; }
                            else { const f32x4 x = *(const f32x4*)(X + off); v = x * DN_ALPHA + v; *(f32x4*)(O + off) = v; }
                        } else {
                            *(f32x4*)(O + off) = v;
                            if (u.ooff2 >= 0) { u32x2 w; w.x = pk2(v[0], v[1]); w.y = pk2(v[2], v[3]); *(u32x2*)(O2 + (size_t)u.ooff2 + (size_t)r * ldc2 + c) = w; }
                        }
                    }
                asm volatile("" ::: "memory");
            }
    }
};

DI void tile_of(int u, int nM, int nN, int& pm, int& pn) {
    const int nig = 8 * nN; const int gid = u / nig; const int fm = gid * 8; const int gsz = (nM - fm) < 8 ? (nM - fm) : 8; const int w = u - gid * nig; pm = fm + w % gsz; pn = w / gsz; }
struct DecDense {
    unsigned A, B; int lda, ldb, ldc, nM, nN, grp, acw, K, ns, ks;
    DI void operator()(int L, GUnit& u) const {
        const int nd = nM * nN;
        if (L < nd) { int pm, pn; tile_of(L, nM, nN, pm, pn);
            u.A = A + (unsigned)(pm * 256 * lda + (pn / grp) * acw) * 2u; u.B = B + (unsigned)(pn * 256 * ldb) * 2u;
            u.ooff = (long)pm * 256 * ldc + (long)pn * 256; u.ooff2 = -1; u.r0 = pm * 256; u.c0 = pn * 256; u.nvalid = 256; u.aux = 0; u.nt = K >> 6; u.kind = 0; }
        else { const int q = L - nd, sl = q / nN, pn = q - sl * nN;
            u.A = A + (unsigned)(RP * lda + (pn / grp) * acw + sl * ks) * 2u; u.B = B + (unsigned)(pn * 256 * ldb + sl * ks) * 2u;
            u.ooff = (long)sl * 256 * ldc + (long)pn * 256; u.ooff2 = -1; u.r0 = RP; u.c0 = pn * 256; u.nvalid = 256; u.aux = 0; u.nt = ks >> 6; u.kind = 1; }
    }
};
struct DecMemKV {
    unsigned mem, wk, wv;
    DI void operator()(int L, GUnit& u) const { const int which = L >> 5, t = L & 31, l = which >> 1, kv = which & 1, pm = t & 3, pn = t >> 2;
        u.A = mem + (unsigned)(pm * 256 * 2048) * 2u; u.B = (kv ? wv : wk) + (unsigned)(l * 2048 * 2048 + pn * 256 * 2048) * 2u;
        u.ooff = (long)(kv ? O_PMEMV : O_PMEMK) + (long)l * 2097152 + (long)pm * 256 * 2048 + pn * 256;
        u.ooff2 = kv ? -1 : ((long)(l * 12 + pm) * 256 * 2048 + pn * 256);
        u.r0 = pm * 256; u.c0 = pn * 256; u.nvalid = 256; u.aux = 0;  u.nt = 32; u.kind = 0; }
};
struct DecMemVT {
    unsigned wv, mem;
    DI void operator()(int L, GUnit& u) const { const int l = L >> 5, t = L & 31, pm = t & 7, pn = t >> 3;
        u.A = wv + (unsigned)(l * 2048 * 2048 + pm * 256 * 2048) * 2u; u.B = mem + (unsigned)(pn * 256 * 2048) * 2u;
        u.ooff = ((long)(l * 12 + pn) * 2048 + pm * 256) * 256; u.ooff2 = -1; u.r0 = pm * 256; u.c0 = 0; u.nvalid = 256; u.aux = 0;  u.nt = 32; u.kind = 0; }
};
struct DecXS {
    unsigned qx, memk;
    DI void operator()(int L, GUnit& u) const {
        int sg, h, r0, nv;
        if (L < 128) { const int panel = L & 7, bh = L >> 3; h = bh & 3; sg = bh >> 2; r0 = sg * 2048 + panel * 256; nv = 256; }
        else { const int s = L - 128; h = s & 3; const int b = s >> 2; sg = 4 + b; r0 = RP + b * 32; nv = 32; }
        u.A = qx + (unsigned)(r0 * 2048 + h * 512) * 2u; u.B = memk + (unsigned)(sg * 256 * 2048 + h * 512) * 2u;
        u.ooff = (long)r0 * 1024 + h * 256; u.ooff2 = -1; u.r0 = r0; u.c0 = 0; u.nvalid = nv; u.aux = h;  u.nt = 8; u.kind = 0; }
};
struct DecXPV {
    unsigned e, memvt;
    DI void operator()(int L, GUnit& u) const {
        int sg, h, half, r0, nv;
        if (L < 256) { const int panel = L & 7, x = L >> 3; half = x & 1; h = (x >> 1) & 3; sg = x >> 3; r0 = sg * 2048 + panel * 256; nv = 256; }
        else { const int s = L - 256; half = s & 1; h = (s >> 1) & 3; const int b = s >> 3; sg = 4 + b; r0 = RP + b * 32; nv = 32; }
        u.A = e + (unsigned)(r0 * 1024 + h * 256) * 2u; u.B = memvt + (unsigned)((sg * 2048 + h * 512 + half * 256) * 256) * 2u;
        u.ooff = (long)r0 * 2048 + h * 512 + half * 256; u.ooff2 = -1; u.r0 = r0; u.c0 = h * 512 + half * 256; u.nvalid = nv; u.aux = h;  u.nt = 4; u.kind = 0; }
};

DI int first_of(int vcu, int G, int off) { int f = vcu - (off % G); return f < 0 ? f + G : f; }

struct Frame {
    LAS unsigned char* lds;
    int tid, lane, wave, G, vcu;
};
DI Frame refresh(const Frame& F0) { Frame F = F0; F.lane = lane_id_asm(); F.tid = F.wave * 64 + F.lane; return F; }

struct TrJob { int in_idx, soff, lds_, tN, doff, ldd, dcol0, rowmap, t0; };
struct TrTab { int n, total; int lstart[5]; TrJob j[112]; };
constexpr TrTab make_trtab() {
    TrTab T{}; int n = 0, t = 0;
    auto add = [&](int in_idx, long soff, int lds_, int K, int N, size_t doff, int ldd, int dcol0, int rowmap) {
        T.j[n] = TrJob{in_idx, (int)soff, lds_, N / 128, (int)doff, ldd, dcol0, rowmap, t}; t += (K / 128) * (N / 128); ++n; };
    for (int l = 0; l < 4; ++l) {
        add(27, (long)l * 2048 * 2048, 2048, 2048, 2048, WS_WK + (size_t)l * 2048 * 2048 * 2, 2048, 0, 0);
        add(28, (long)l * 2048 * 2048, 2048, 2048, 2048, WS_WV + (size_t)l * 2048 * 2048 * 2, 2048, 0, 0);
        for (int b = 0; b < 8; ++b)
            add(4, ((long)l * 8 + b) * 256 * 2048, 2048, 256, 2048, WS_MEMVT + ((size_t)l * 12 + 4 + b) * 2048 * 256 * 2, 256, 0, 0);
    }
    for (int j = 0; j < 2; ++j) {
        add(10, (long)j * 2048 * INC, INC, 2048, 2816, WS_WIN + (size_t)j * INP * 2048 * 2, 2048, 0, 0);
        add(23, (long)j * 2048 * 2048, 2048, 2048, 2048, WS_WOUT + (size_t)j * 2048 * 2048 * 2, 2048, 0, 0);
        add(12, (long)j * 512 * 1536, 1536, 512, 1536, WS_WUQ + (size_t)j * 1536 * 512 * 2, 512, 0, 1);
        add(14, (long)j * 256 * 1024, 1024, 256, 1024, WS_WUK + (size_t)j * 1024 * 256 * 2, 256, 0, 0);
        add(15, (long)j * 256 * 1024, 1024, 256, 1024, WS_WUV + (size_t)j * 1024 * 256 * 2, 256, 0, 0);
        for (int g = 0; g < 4; ++g)
            add(24, ((long)j * 4 + g) * 512 * 512, 512, 512, 512, WS_WPOOL + ((size_t)j * 2048 * 512 + (size_t)g * 512 * 512) * 2, 512, 0, 0);
        for (int h = 0; h < 8; ++h) {
            add(18, ((long)j * 8 + h) * 128 * 128, 128, 128, 128, WS_WGT + ((size_t)j * 2048 * 256 + (size_t)h * 256 * 256) * 2, 256, (h & 1) * 128, 0);
            add(20, ((long)j * 8 + h) * 128 * 128, 128, 128, 128, WS_WGT + ((size_t)j * 2048 * 256 + (size_t)h * 256 * 256 + 128 * 256) * 2, 256, (h & 1) * 128, 0);
        }
    }
    for (int l = 0; l < 4; ++l) {
        T.lstart[l] = t;
        add(26, (long)l * 2048 * 2048, 2048, 2048, 2048, WS_WQ + (size_t)l * 2048 * 2048 * 2, 2048, 0, 0);
        add(29, (long)l * 2048 * 2048, 2048, 2048, 2048, WS_WO + (size_t)l * 2048 * 2048 * 2, 2048, 0, 0);
        add(30, (long)l * 2048 * 8192, 8192, 2048, 8192, WS_WUP + (size_t)l * 8192 * 2048 * 2, 2048, 0, 0);
        add(31, (long)l * 8192 * 2048, 2048, 8192, 2048, WS_WDN + (size_t)l * 2048 * 8192 * 2, 8192, 0, 0);
    }
    T.lstart[4] = t;
    T.n = n; T.total = t; return T;
}
__device__ const TrTab g_trtab = make_trtab();
static_assert(make_trtab().n <= 112, "job table size");

DI int uq_rowmap(int n) { const int h = n / 192, d = n - h * 192; if (d < 128) return n; const int e = d - 128; return h * 192 + 128 + 2 * (e & 31) + (e >> 5); }
DI void tr_range(const Frame& F, const Params& p, int t_begin, int t_end, int rank, int nranks) {
    LAS float* tile = (LAS float*)(F.lds + STAGE_OFF);
    const int njobs = g_trtab.n;
    if (rank < 0 || t_begin + rank >= t_end) return;
    int ji = 0;
    f32x4 va[8], vb[8]; TrJob ja, jb; int ta = t_begin + rank, tb = ta + nranks;
#define TR_LOAD(v_, j_, t_) do { if ((t_) < t_end) { while (ji + 1 < njobs && (t_) >= g_trtab.j[ji + 1].t0) ++ji; j_ = g_trtab.j[ji]; \
        const int q_ = (t_) - j_.t0, tk_ = q_ / j_.tN, tn_ = q_ - tk_ * j_.tN; const float* s_ = p.in[j_.in_idx] + j_.soff + (size_t)(tk_ * 128) * j_.lds_ + tn_ * 128; \
        _Pragma("unroll") for (int i_ = 0; i_ < 8; ++i_) { const int idx_ = F.tid + i_ * 512; v_[i_] = *(const f32x4*)(s_ + (size_t)(idx_ >> 5) * j_.lds_ + (idx_ & 31) * 4); } } } while (0)
#define TR_PROC(v_, j_, t_, tnext_) do { \
        const TrJob cj_ = j_; const int q_ = (t_) - cj_.t0, tk_ = q_ / cj_.tN, tn_ = q_ - tk_ * cj_.tN; \
        _Pragma("unroll") for (int i_ = 0; i_ < 8; ++i_) { const int idx_ = F.tid + i_ * 512; *(LAS f32x4*)(tile + (idx_ >> 5) * 132 + (idx_ & 31) * 4) = v_[i_]; } \
        TR_LOAD(v_, j_, tnext_); \
        __syncthreads(); \
        bf16_t* dst_ = (bf16_t*)(p.ws + (size_t)(unsigned)cj_.doff); \
        _Pragma("unroll") for (int i_ = 0; i_ < 4; ++i_) { const int n_ = F.tid & 127, k8_ = ((F.tid >> 7) + 4 * i_) * 8; u32x4 w_; \
            w_.x = pk2(tile[(k8_ + 0) * 132 + n_], tile[(k8_ + 1) * 132 + n_]); w_.y = pk2(tile[(k8_ + 2) * 132 + n_], tile[(k8_ + 3) * 132 + n_]); \
            w_.z = pk2(tile[(k8_ + 4) * 132 + n_], tile[(k8_ + 5) * 132 + n_]); w_.w = pk2(tile[(k8_ + 6) * 132 + n_], tile[(k8_ + 7) * 132 + n_]); \
            const int ng_ = tn_ * 128 + n_; const int nr_ = cj_.rowmap ? uq_rowmap(ng_) : ng_; \
            *(u32x4*)(dst_ + (size_t)nr_ * cj_.ldd + cj_.dcol0 + tk_ * 128 + k8_) = w_; } \
        __syncthreads(); } while (0)
    TR_LOAD(va, ja, ta); jb = ja; TR_LOAD(vb, jb, tb);
    for (;;) {
        const int tc = tb + nranks;
        TR_PROC(va, ja, ta, tc);
        if (tb >= t_end) break;
        const int td = tc + nranks;
        TR_PROC(vb, jb, tb, td);
        if (tc >= t_end) break;
        ta = tc; tb = td;
    }
#undef TR_LOAD
#undef TR_PROC
}
DI void cvt_job(const Frame& F, const float* src, bf16_t* dst, float* dstf, size_t n) {
    const size_t n4 = n >> 2, st = (size_t)F.G * 512;
    size_t i = (size_t)F.vcu * 512 + F.tid;
    for (; i + 3 * st < n4; i += 4 * st) {
        f32x4 v[4];
#pragma unroll
        for (int u = 0; u < 4; ++u) v[u] = *(const f32x4*)(src + (i + u * st) * 4);
#pragma unroll
        for (int u = 0; u < 4; ++u) { u32x2 w; w.x = pk2(v[u][0], v[u][1]); w.y = pk2(v[u][2], v[u][3]); *(u32x2*)(dst + (i + u * st) * 4) = w; if (dstf) *(f32x4*)(dstf + (i + u * st) * 4) = v[u]; }
    }
    for (; i < n4; i += st) {
        const f32x4 v = *(const f32x4*)(src + i * 4);
        u32x2 w; w.x = pk2(v[0], v[1]); w.y = pk2(v[2], v[3]);
        *(u32x2*)(dst + i * 4) = w;
        if (dstf) *(f32x4*)(dstf + i * 4) = v;
    }
}
DI void zero_job(const Frame& F, void* dst, size_t bytes) {
    const size_t n = bytes >> 4;
    for (size_t i = (size_t)F.vcu * 512 + F.tid; i < n; i += (size_t)F.G * 512) ((u32x4*)dst)[i] = (u32x4){0u, 0u, 0u, 0u};
}

DI void p0_prologue(const Frame& F0, const Params& p) {
    const Frame F = refresh(F0);
    unsigned char* ws = p.ws;
    tr_range(F, p, 0, g_trtab.lstart[1], F.vcu, F.G);
    for (int l = 0; l < 4; ++l)
        cvt_job(F, p.in[3] + (size_t)l * 8 * 256 * 2048, (bf16_t*)(ws + WS_MEMK) + ((size_t)l * 12 + 4) * 256 * 2048, nullptr, (size_t)8 * 256 * 2048);
    for (int j = 0; j < 2; ++j) {
        const float* src = p.in[10] + (size_t)j * 2048 * INC; bf16_t* dst = (bf16_t*)(ws + WS_WIN) + (size_t)j * INP * 2048;
        for (int i = F.vcu * 512 + F.tid; i < 64 * 2048; i += F.G * 512) { const int k = i >> 6, n = 2816 + (i & 63); dst[(size_t)n * 2048 + k] = (bf16_t)(pk2(src[(size_t)k * INC + n], 0.f) & 0xffffu); }
        zero_job(F, dst + (size_t)INC * 2048, (size_t)(INP - INC) * 2048 * 2);
        bf16_t* g = (bf16_t*)(ws + WS_WGT) + (size_t)j * 2048 * 256;
        for (int i = F.vcu * 512 + F.tid; i < 2048 * 16; i += F.G * 512) { const int row = i >> 4, c8 = (i & 15) * 8; const int h = row >> 8; *(u32x4*)(g + (size_t)row * 256 + (1 - (h & 1)) * 128 + c8) = (u32x4){0u, 0u, 0u, 0u}; }
    }
    cvt_job(F, p.in[0], (bf16_t*)(ws + WS_XB), (float*)(ws + WS_XF), (size_t)RP * D);
    cvt_job(F, p.in[1], (bf16_t*)(ws + WS_XB) + (size_t)RP * D, (float*)(ws + WS_XF) + (size_t)RP * D, (size_t)RS * D);
    cvt_job(F, p.in[2], (bf16_t*)(ws + WS_MEMBF), nullptr, (size_t)1024 * 2048);
    for (int j = 0; j < 2; ++j) {
        bf16_t* ck = (bf16_t*)(ws + WS_CKV) + (size_t)j * KEYSPAD * 256; bf16_t* kp = (bf16_t*)(ws + WS_KPE) + (size_t)j * KEYSPAD * 64;
        const float* sck = p.in[5] + (size_t)j * 8 * 1024 * 256; const float* skp = p.in[6] + (size_t)j * 8 * 1024 * 64;
        for (int i = F.vcu * 512 + F.tid; i < 8 * 1024 * 64; i += F.G * 512) {
            const int row = i >> 6, c4 = (i & 63) * 4, b = row >> 10, t = row & 1023;
            const f32x4 v = *(const f32x4*)(sck + (size_t)row * 256 + c4); u32x2 w; w.x = pk2(v[0], v[1]); w.y = pk2(v[2], v[3]);
            *(u32x2*)(ck + (size_t)(RP + b * 1056 + t) * 256 + c4) = w; }
        for (int i = F.vcu * 512 + F.tid; i < 8 * 1024 * 32; i += F.G * 512) {
            const int row = i >> 5, ii = i & 31, b = row >> 10, t = row & 1023;
            const float x1 = skp[(size_t)row * 64 + ii], x2 = skp[(size_t)row * 64 + 32 + ii];
            *(unsigned*)(kp + (size_t)(RP + b * 1056 + t) * 64 + 2 * ii) = pk2(x1, x2); }
    }
    { float* gb = (float*)(ws + WS_CTL + 32768);
      for (int i = F.vcu * 512 + F.tid; i < 2 * 2048; i += F.G * 512) { const int jj = i >> 11, h = (i >> 8) & 7, e = i & 255;
          gb[i] = e < 128 ? p.in[19][((size_t)jj * 8 + h) * 128 + e] : p.in[21][((size_t)jj * 8 + h) * 128 + (e - 128)]; } }
    { float* rc = (float*)(ws + WS_ROPE); float* rsn = rc + 2048 * 32;
      for (int i = F.vcu * 512 + F.tid; i < 2048 * 32; i += F.G * 512) { const int pos = i >> 5, ii = i & 31;
          const float inv = powf(10000.0f, -(float)ii / 32.0f); const float ang = (float)pos * inv; rc[i] = (float)cos((double)ang); rsn[i] = (float)sin((double)ang); } }
}

DI void ln_row(const f32x4 (&v)[8], int lane, const float* g, const float* b, float* xfr, bf16_t* xbr) {
    float s = 0.f;
#pragma unroll
    for (int i = 0; i < 8; ++i) s += (v[i][0] + v[i][1]) + (v[i][2] + v[i][3]);
#pragma unroll
    for (int o = 32; o >= 1; o >>= 1) s += __shfl_xor(s, o);
    const float mu = s * (1.0f / D); float q = 0.f;
#pragma unroll
    for (int i = 0; i < 8; ++i) { const f32x4 d = v[i] - mu; q += (d[0] * d[0] + d[1] * d[1]) + (d[2] * d[2] + d[3] * d[3]); }
#pragma unroll
    for (int o = 32; o >= 1; o >>= 1) q += __shfl_xor(q, o);
    const float rstd = rsqrtf(q * (1.0f / D) + LN_EPS);
#pragma unroll
    for (int i = 0; i < 8; ++i) { const int c = (i * 64 + lane) * 4;
        const f32x4 gg = *(const f32x4*)(g + c), bb = *(const f32x4*)(b + c);
        const f32x4 o = (v[i] - mu) * rstd * gg + bb;
        *(f32x4*)(xfr + c) = o;
        u32x2 w; w.x = pk2(o[0], o[1]); w.y = pk2(o[2], o[3]); *(u32x2*)(xbr + c) = w; }
}
DI void ln_phase(const Frame& F0, const float* tb, const float* g, const float* b, float* xf, bf16_t* xb, const float* slab, int ns, bool do_sample) {
    const Frame F = refresh(F0);
    for (int r = F.vcu * 8 + F.wave; r < RP; r += F.G * 8) {
        const float* src = tb + (size_t)r * D;
        f32x4 v[8];
#pragma unroll
        for (int i = 0; i < 8; ++i) v[i] = *(const f32x4*)(src + (i * 64 + F.lane) * 4);
        ln_row(v, F.lane, g, b, xf + (size_t)r * D, xb + (size_t)r * D);
    }
    const float* xin = (const float*)((const unsigned char*)tb - WS_TB + WS_XF);
    LAS float* red = (LAS float*)(F.lds + STAGE_OFF);
    if (do_sample) for (int sr = F.vcu; sr < RS; sr += F.G) {
        f32x4 a[8];
#pragma unroll
        for (int i = 0; i < 8; ++i) a[i] = (f32x4){0.f, 0.f, 0.f, 0.f};
        for (int sl = F.wave; sl < ns; sl += 8) {
            const float* src = slab + ((size_t)sl * 256 + sr) * D;
#pragma unroll
            for (int i = 0; i < 8; ++i) a[i] += *(const f32x4*)(src + (i * 64 + F.lane) * 4);
        }
#pragma unroll
        for (int i = 0; i < 8; ++i) *(LAS f32x4*)(red + F.wave * 2048 + (i * 64 + F.lane) * 4) = a[i];
        __syncthreads();
        if (F.wave == 0) {
            const size_t r = (size_t)RP + sr;
            f32x4 v[8];
#pragma unroll
            for (int i = 0; i < 8; ++i) { const int c = (i * 64 + F.lane) * 4; f32x4 t = *(const f32x4*)(xin + r * D + c) * DN_ALPHA;
#pragma unroll
                for (int w = 0; w < 8; ++w) t += *(const LAS f32x4*)(red + w * 2048 + c);
                v[i] = t; }
            ln_row(v, F.lane, g, b, xf + r * D, xb + r * D);
        }
        __syncthreads();
    }
}

DI void e2_phase(const Frame& F0, const Params& p, int j) {
    const Frame F = refresh(F0);
    unsigned char* ws = p.ws;
    const bf16_t* zb = (const bf16_t*)(ws + WS_ZB);
    bf16_t* ucb = (bf16_t*)(ws + WS_UCB); bf16_t* cqn = (bf16_t*)(ws + WS_CQN);
    bf16_t* ckv = (bf16_t*)(ws + WS_CKV) + (size_t)j * KEYSPAD * 256; bf16_t* kpe = (bf16_t*)(ws + WS_KPE) + (size_t)j * KEYSPAD * 64;
    const float* rc = (const float*)(ws + WS_ROPE); const float* rsn = rc + 2048 * 32;
    const float* cw = p.in[16] + (size_t)j * 4 * 1024; const float* cb = p.in[17] + (size_t)j * 1024;
    const float* qg = p.in[11] + (size_t)j * 512; const float* kg = p.in[13] + (size_t)j * 256;
    const float* cst = p.in[8] + (size_t)j * 8 * 3 * 1024;
    const int lane = F.lane;
    float cwr[2][4][8], cbr[2][8];
#pragma unroll
    for (int g = 0; g < 2; ++g) {
        const int c = g * 512 + lane * 8;
#pragma unroll
        for (int k = 0; k < 4; ++k) { const f32x4 w0 = *(const f32x4*)(cw + k * 1024 + c), w1 = *(const f32x4*)(cw + k * 1024 + c + 4);
            cwr[g][k][0] = w0[0]; cwr[g][k][1] = w0[1]; cwr[g][k][2] = w0[2]; cwr[g][k][3] = w0[3]; cwr[g][k][4] = w1[0]; cwr[g][k][5] = w1[1]; cwr[g][k][6] = w1[2]; cwr[g][k][7] = w1[3]; }
        const f32x4 b0 = *(const f32x4*)(cb + c), b1 = *(const f32x4*)(cb + c + 4);
        cbr[g][0] = b0[0]; cbr[g][1] = b0[1]; cbr[g][2] = b0[2]; cbr[g][3] = b0[3]; cbr[g][4] = b1[0]; cbr[g][5] = b1[1]; cbr[g][6] = b1[2]; cbr[g][7] = b1[3];
    }
    const f32x4 qg0 = *(const f32x4*)(qg + lane * 8), qg1 = *(const f32x4*)(qg + lane * 8 + 4), kg0 = *(const f32x4*)(kg + lane * 4);
    for (int r = F.vcu * 8 + F.wave; r < R; r += F.G * 8) {
        const bool smp = r >= RP; const int b = smp ? ((r - RP) >> 5) : (r >> 11); const int t = smp ? ((r - RP) & 31) : (r & 2047);
        const int pos = smp ? 1024 + t : t; const int T = smp ? 32 : 2048;
        const bf16_t* zr = zb + (size_t)r * INP;
#pragma unroll
        for (int g = 0; g < 2; ++g) {
            const int c = g * 512 + lane * 8;
            float uu[4][8];
#pragma unroll
            for (int k = 0; k < 4; ++k) {
                const int tt = t - 3 + k;
                if (tt >= 0) { const u32x4 w = *(const u32x4*)(zr + (long)(k - 3) * INP + c);
                    uu[k][0] = bflo(w.x); uu[k][1] = bfhi(w.x); uu[k][2] = bflo(w.y); uu[k][3] = bfhi(w.y); uu[k][4] = bflo(w.z); uu[k][5] = bfhi(w.z); uu[k][6] = bflo(w.w); uu[k][7] = bfhi(w.w); }
                else if (smp) { const float* s = cst + ((size_t)b * 3 + (3 + tt)) * 1024 + c; const f32x4 a = *(const f32x4*)s, bq = *(const f32x4*)(s + 4);
                    uu[k][0] = a[0]; uu[k][1] = a[1]; uu[k][2] = a[2]; uu[k][3] = a[3]; uu[k][4] = bq[0]; uu[k][5] = bq[1]; uu[k][6] = bq[2]; uu[k][7] = bq[3]; }
                else {
#pragma unroll
                    for (int e = 0; e < 8; ++e) uu[k][e] = 0.f; }
            }
            float o[8];
#pragma unroll
            for (int e = 0; e < 8; ++e) o[e] = cbr[g][e];
#pragma unroll
            for (int k = 0; k < 4; ++k)
#pragma unroll
                for (int e = 0; e < 8; ++e) o[e] += cwr[g][k][e] * uu[k][e];
            u32x4 w; w.x = pk2(o[0], o[1]); w.y = pk2(o[2], o[3]); w.z = pk2(o[4], o[5]); w.w = pk2(o[6], o[7]);
            *(u32x4*)(ucb + (size_t)r * 1024 + c) = w;
            if (t >= T - 3) {
                float* dst = smp ? (p.out + O_SCONV + (((size_t)j * 8 + b) * 3 + (t - (T - 3))) * 1024 + c) : (p.out + O_PCONV + (((size_t)j * 4 + b) * 3 + (t - (T - 3))) * 1024 + c);
                *(f32x4*)dst = (f32x4){uu[3][0], uu[3][1], uu[3][2], uu[3][3]}; *(f32x4*)(dst + 4) = (f32x4){uu[3][4], uu[3][5], uu[3][6], uu[3][7]};
            }
        }
        {
            const u32x4 w = *(const u32x4*)(zr + 2048 + lane * 8);
            float x[8] = {bflo(w.x), bfhi(w.x), bflo(w.y), bfhi(w.y), bflo(w.z), bfhi(w.z), bflo(w.w), bfhi(w.w)};
            float ss = 0.f;
#pragma unroll
            for (int e = 0; e < 8; ++e) ss += x[e] * x[e];
#pragma unroll
            for (int o = 32; o >= 1; o >>= 1) ss += __shfl_xor(ss, o);
            const float rs = rsqrtf(ss * (1.0f / 512.0f) + RMS_EPS);
            const f32x4 g0 = qg0, g1 = qg1;
            u32x4 ow; ow.x = pk2(x[0] * rs * g0[0], x[1] * rs * g0[1]); ow.y = pk2(x[2] * rs * g0[2], x[3] * rs * g0[3]);
            ow.z = pk2(x[4] * rs * g1[0], x[5] * rs * g1[1]); ow.w = pk2(x[6] * rs * g1[2], x[7] * rs * g1[3]);
            *(u32x4*)(cqn + (size_t)r * 512 + lane * 8) = ow;
        }
        const size_t krow = smp ? (size_t)(RP + b * 1056 + 1024 + t) : (size_t)r;
        {
            const u32x2 w = *(const u32x2*)(zr + 2560 + lane * 4);
            float x[4] = {bflo(w.x), bfhi(w.x), bflo(w.y), bfhi(w.y)};
            float ss = (x[0] * x[0] + x[1] * x[1]) + (x[2] * x[2] + x[3] * x[3]);
#pragma unroll
            for (int o = 32; o >= 1; o >>= 1) ss += __shfl_xor(ss, o);
            const float rs = rsqrtf(ss * (1.0f / 256.0f) + RMS_EPS);
            const f32x4 g0 = kg0;
            const f32x4 o = (f32x4){x[0] * rs * g0[0], x[1] * rs * g0[1], x[2] * rs * g0[2], x[3] * rs * g0[3]};
            float* dst = smp ? (p.out + O_SCKV + (((size_t)j * 8 + b) * 32 + t) * 256 + lane * 4) : (p.out + O_PCKV + (((size_t)j * 4 + b) * 2048 + t) * 256 + lane * 4);
            *(f32x4*)dst = o;
            u32x2 ow; ow.x = pk2(o[0], o[1]); ow.y = pk2(o[2], o[3]); *(u32x2*)(ckv + krow * 256 + lane * 4) = ow;
        }
        if (lane < 32) {
            const float x1 = bf2f(zr[2816 + lane]), x2 = bf2f(zr[2816 + 32 + lane]);
            const float cs = rc[pos * 32 + lane], sn = rsn[pos * 32 + lane];
            const float o1 = x1 * cs - x2 * sn, o2 = x1 * sn + x2 * cs;
            float* dst = smp ? (p.out + O_SKPE + (((size_t)j * 8 + b) * 32 + t) * 64) : (p.out + O_PKPE + (((size_t)j * 4 + b) * 2048 + t) * 64);
            dst[lane] = o1; dst[32 + lane] = o2;
            *(unsigned*)(kpe + krow * 64 + 2 * lane) = pk2(o1, o2);
        }
    }
}

DI float gelu_tanh(float x) { const float y = 0.7978845608028654f * (x + 0.044715f * x * x * x); const float e = __expf(2.0f * y); const float th = 1.0f - 2.0f / (e + 1.0f); return 0.5f * x * (1.0f + th); }
DI float one_minus_exp(float x) {
    return (x > -0.02f) ? -x * (1.0f + x * (0.5f + x * (0.16666667f + x * 0.041666668f))) : 1.0f - __expf(x); }
DI void scan_phase(const Frame& F0, const Params& p, int j) {
    const Frame F = refresh(F0);
    unsigned char* ws = p.ws;
    const bf16_t* zb = (const bf16_t*)(ws + WS_ZB); const bf16_t* ucb = (const bf16_t*)(ws + WS_UCB); const bf16_t* gat = (const bf16_t*)(ws + WS_GAT);
    bf16_t* mix = (bf16_t*)(ws + WS_MIX);
    const float* lam = p.in[22] + (size_t)j * 1024;
    LAS float* sA = (LAS float*)(F.lds + STAGE_OFF); LAS float* sB = sA + 512;
    for (int task = F.vcu; task < 272; task += F.G) {
        if (task < 256) {
            const int b = task >> 6, cbk = task & 63, seg = F.tid >> 4, ch = cbk * 16 + (F.tid & 15);
            const float clam = -8.0f * log1pf(expf(-lam[ch]));
            const size_t row0 = (size_t)b * 2048 + seg * 64;
            const bf16_t* pr = gat + row0 * 2048 + (ch >> 7) * 256 + (ch & 127);
            const bf16_t* pu = ucb + row0 * 1024 + ch;
            float h = 0.f, Aacc = 1.f;
#pragma unroll 16
            for (int s = 0; s < 64; ++s) {
                const float rr = bf2f(pr[(size_t)s * 2048]), ig = bf2f(pr[(size_t)s * 2048 + 128]), u = bf2f(pu[(size_t)s * 1024]);
                const float la = clam * rr, a = __expf(la), mult = sqrtf(one_minus_exp(2.0f * la));
                h = a * h + mult * (ig * u); Aacc *= a;
            }
            sA[seg * 16 + (F.tid & 15)] = Aacc; sB[seg * 16 + (F.tid & 15)] = h;
            __syncthreads();
            float hin = 0.f;
            for (int s2 = 0; s2 < seg; ++s2) hin = sA[s2 * 16 + (F.tid & 15)] * hin + sB[s2 * 16 + (F.tid & 15)];
            h = hin;
            const bf16_t* pg = zb + row0 * INP + 1024 + ch;
            bf16_t* po = mix + row0 * 2048 + ch;
#pragma unroll 16
            for (int s = 0; s < 64; ++s) {
                const float rr = bf2f(pr[(size_t)s * 2048]), ig = bf2f(pr[(size_t)s * 2048 + 128]), u = bf2f(pu[(size_t)s * 1024]), gt = bf2f(pg[(size_t)s * INP]);
                const float la = clam * rr, a = __expf(la), mult = sqrtf(one_minus_exp(2.0f * la));
                h = a * h + mult * (ig * u);
                po[(size_t)s * 2048] = (bf16_t)(pk2(h * gelu_tanh(gt), 0.f) & 0xffffu);
            }
            if (seg == 31) p.out[O_PH + ((size_t)j * 4 + b) * 1024 + ch] = h;
            __syncthreads();
        } else {
            const int s0 = task - 256, b = s0 >> 1, ch = (s0 & 1) * 512 + F.tid;
            const float clam = -8.0f * log1pf(expf(-lam[ch]));
            const size_t row0 = (size_t)RP + b * 32;
            const bf16_t* pr = gat + row0 * 2048 + (ch >> 7) * 256 + (ch & 127);
            const bf16_t* pu = ucb + row0 * 1024 + ch;
            const bf16_t* pg = zb + row0 * INP + 1024 + ch;
            bf16_t* po = mix + row0 * 2048 + ch;
            float h = p.in[7][((size_t)j * 8 + b) * 1024 + ch];
#pragma unroll 8
            for (int s = 0; s < 32; ++s) {
                const float rr = bf2f(pr[(size_t)s * 2048]), ig = bf2f(pr[(size_t)s * 2048 + 128]), u = bf2f(pu[(size_t)s * 1024]), gt = bf2f(pg[(size_t)s * INP]);
                const float la = clam * rr, a = __expf(la), mult = sqrtf(one_minus_exp(2.0f * la));
                h = a * h + mult * (ig * u);
                po[(size_t)s * 2048] = (bf16_t)(pk2(h * gelu_tanh(gt), 0.f) & 0xffffu);
            }
            p.out[O_SH + ((size_t)j * 8 + b) * 1024 + ch] = h;
        }
    }
}

constexpr int AT_KROW = 400, AT_VROW = 136, AT_KBYTES = 64 * AT_KROW, AT_VBYTES = 128 * AT_VROW, AT_BUF = 44032;
DI void attn_phase(const Frame& F0, const Params& p, int j) {
    const Frame F = refresh(F0);
    unsigned char* ws = p.ws;
    const bf16_t* Q = (const bf16_t*)(ws + WS_Q); const bf16_t* Kn = (const bf16_t*)(ws + WS_KN); const bf16_t* VT = (const bf16_t*)(ws + WS_VT);
    const bf16_t* kpe = (const bf16_t*)(ws + WS_KPE) + (size_t)j * KEYSPAD * 64;
    bf16_t* mix = (bf16_t*)(ws + WS_MIX);
    const int tid = F.tid, w = F.wave, lane = F.lane, r32 = lane & 31, hf = lane >> 5;
    for (int slot = F.vcu; slot < 512; slot += F.G) {
        const int item = slot < 256 ? slot : 767 - slot;
        if (item >= 320) continue;
        int h, qrow0, kb0, ntiles, my_tiles, nkeys;
        if (item < 256) { const int qb = 7 - (item >> 5), rem = item & 31, b = rem >> 3; h = rem & 7;
            qrow0 = b * 2048 + qb * 256 + w * 32; kb0 = b * 2048; ntiles = qb * 4 + 4; my_tiles = qb * 4 + (w >> 1) + 1; nkeys = ntiles * 64; }
        else { const int s = item - 256, b = s >> 3; h = s & 7; qrow0 = RP + b * 32; kb0 = RP + b * 1056; ntiles = 17; my_tiles = (w == 0) ? 17 : 0; nkeys = 1056; }
        bf16x8 qf[12];
        if (my_tiles > 0) {
#pragma unroll
            for (int ks = 0; ks < 12; ++ks) qf[ks] = *(const bf16x8*)(Q + (size_t)(qrow0 + r32) * 1536 + h * 192 + ks * 16 + hf * 8);
        } else {
#pragma unroll
            for (int ks = 0; ks < 12; ++ks) qf[ks] = (bf16x8){0, 0, 0, 0, 0, 0, 0, 0};
        }
        u32x4 kreg[3], vreg[2];
#define AT_LOAD_TILE(kt_) do { \
            _Pragma("unroll") for (int i_ = 0; i_ < 3; ++i_) { const int q_ = tid + 512 * i_; const int key_ = q_ / 24, part_ = q_ - key_ * 24; \
                int kk_ = (kt_) * 64 + key_; kk_ = kk_ < nkeys ? kk_ : nkeys - 1; const size_t krow_ = (size_t)kb0 + kk_; \
                const bf16_t* src_ = part_ < 16 ? (Kn + krow_ * 1024 + h * 128 + part_ * 8) : (kpe + krow_ * 64 + (part_ - 16) * 8); \
                kreg[i_] = *(const u32x4*)src_; } \
            _Pragma("unroll") for (int i_ = 0; i_ < 2; ++i_) { const int q_ = tid + 512 * i_; const int dv_ = q_ >> 3, part_ = q_ & 7; \
                int kc_ = (kt_) * 64 + part_ * 8; kc_ = kc_ <= nkeys - 8 ? kc_ : nkeys - 8; \
                vreg[i_] = *(const u32x4*)(VT + (size_t)(h * 128 + dv_) * KEYS + kb0 + kc_); } } while (0)
#define AT_STORE_TILE(buf_) do { \
            LAS unsigned char* kb_ = F.lds + STAGE_OFF + (buf_) * AT_BUF; LAS unsigned char* vb_ = kb_ + AT_KBYTES; \
            _Pragma("unroll") for (int i_ = 0; i_ < 3; ++i_) { const int q_ = tid + 512 * i_; const int key_ = q_ / 24, part_ = q_ - key_ * 24; *(LAS u32x4*)(kb_ + key_ * AT_KROW + part_ * 16) = kreg[i_]; } \
            _Pragma("unroll") for (int i_ = 0; i_ < 2; ++i_) { const int q_ = tid + 512 * i_; const int dv_ = q_ >> 3, part_ = q_ & 7; \
                *(LAS u32x2*)(vb_ + dv_ * AT_VROW + part_ * 16) = (u32x2){vreg[i_].x, vreg[i_].y}; *(LAS u32x2*)(vb_ + dv_ * AT_VROW + part_ * 16 + 8) = (u32x2){vreg[i_].z, vreg[i_].w}; } } while (0)
        f32x16 o[4];
#pragma unroll
        for (int d = 0; d < 4; ++d)
#pragma unroll
            for (int i = 0; i < 16; ++i) o[d][i] = 0.f;
        float m_run = -INFINITY, l_run = 0.f;
        AT_LOAD_TILE(0); AT_STORE_TILE(0);
        __syncthreads();
        for (int kt = 0; kt < ntiles; ++kt) {
            const int buf = kt & 1;
            if (kt + 1 < ntiles) AT_LOAD_TILE(kt + 1);
            if (kt < my_tiles) {
                const LAS unsigned char* kb = F.lds + STAGE_OFF + buf * AT_BUF; const LAS unsigned char* vb = kb + AT_KBYTES;
                f32x16 s0, s1;
#pragma unroll
                for (int i = 0; i < 16; ++i) { s0[i] = 0.f; s1[i] = 0.f; }
#pragma unroll
                for (int ks = 0; ks < 12; ++ks) {
                    const bf16x8 a0 = *(const LAS bf16x8*)(kb + r32 * AT_KROW + ks * 32 + hf * 16);
                    const bf16x8 a1 = *(const LAS bf16x8*)(kb + (32 + r32) * AT_KROW + ks * 32 + hf * 16);
                    s0 = __builtin_amdgcn_mfma_f32_32x32x16_bf16(a0, qf[ks], s0, 0, 0, 0);
                    s1 = __builtin_amdgcn_mfma_f32_32x32x16_bf16(a1, qf[ks], s1, 0, 0, 0);
                }
                const float sc = 0.07216878364870322f * 1.4426950408889634f;
                const bool tail = (kt * 64 + 64) > nkeys;
                float mx = -INFINITY;
#pragma unroll
                for (int i = 0; i < 16; ++i) {
                    const int key0 = kt * 64 + (i & 3) + 8 * (i >> 2) + 4 * hf;
                    float a = s0[i] * sc, bq = s1[i] * sc;
                    if (tail) { if (key0 >= nkeys) a = -INFINITY; if (key0 + 32 >= nkeys) bq = -INFINITY; }
                    s0[i] = a; s1[i] = bq; mx = fmaxf(mx, fmaxf(a, bq));
                }
                mx = fmaxf(mx, __shfl_xor(mx, 32));
                const float m_new = fmaxf(m_run, mx);
                const float alpha = __builtin_amdgcn_exp2f(m_run - m_new);
                float ls = 0.f;
#pragma unroll
                for (int i = 0; i < 16; ++i) { s0[i] = __builtin_amdgcn_exp2f(s0[i] - m_new); s1[i] = __builtin_amdgcn_exp2f(s1[i] - m_new); ls += s0[i] + s1[i]; }
                l_run = l_run * alpha + ls; m_run = m_new;
#pragma unroll
                for (int d = 0; d < 4; ++d)
#pragma unroll
                    for (int i = 0; i < 16; ++i) o[d][i] *= alpha;
#pragma unroll
                for (int s = 0; s < 4; ++s) {
                    u32x4 pw;
                    if (s < 2) { const int e = (s & 1) * 8; pw.x = pk2(s0[e + 0], s0[e + 1]); pw.y = pk2(s0[e + 2], s0[e + 3]); pw.z = pk2(s0[e + 4], s0[e + 5]); pw.w = pk2(s0[e + 6], s0[e + 7]); }
                    else { const int e = (s & 1) * 8; pw.x = pk2(s1[e + 0], s1[e + 1]); pw.y = pk2(s1[e + 2], s1[e + 3]); pw.z = pk2(s1[e + 4], s1[e + 5]); pw.w = pk2(s1[e + 6], s1[e + 7]); }
                    const bf16x8 pf = __builtin_bit_cast(bf16x8, pw);
#pragma unroll
                    for (int d = 0; d < 4; ++d) {
                        const LAS unsigned char* va = vb + (d * 32 + r32) * AT_VROW + (s * 16 + 4 * hf) * 2;
                        const s16x4 lo = *(const LAS s16x4*)va, hi = *(const LAS s16x4*)(va + 16);
                        const bf16x8 vf = __builtin_shufflevector(lo, hi, 0, 1, 2, 3, 4, 5, 6, 7);
                        o[d] = __builtin_amdgcn_mfma_f32_32x32x16_bf16(vf, pf, o[d], 0, 0, 0);
                    }
                }
            }
            if (kt + 1 < ntiles) AT_STORE_TILE(buf ^ 1);
            __syncthreads();
        }
        if (my_tiles > 0) {
            const float l = l_run + __shfl_xor(l_run, 32);
            const float inv = 1.0f / l;
            bf16_t* orow = mix + (size_t)(qrow0 + r32) * 2048 + 1024 + h * 128;
#pragma unroll
            for (int d = 0; d < 4; ++d)
#pragma unroll
                for (int g = 0; g < 4; ++g) {
                    u32x2 wv; wv.x = pk2(o[d][4 * g + 0] * inv, o[d][4 * g + 1] * inv); wv.y = pk2(o[d][4 * g + 2] * inv, o[d][4 * g + 3] * inv);
                    *(u32x2*)(orow + d * 32 + 8 * g + 4 * hf) = wv;
                }
        }
    }
}

template <int W> DI void pool_seg(const float* xf, const float* pst, bf16_t* pd, float* out, int j, int r0, int c) {
    const bool smp = r0 >= RP; const int b = smp ? ((r0 - RP) >> 5) : (r0 >> 11); const int t0 = smp ? ((r0 - RP) & 31) : (r0 & 2047);
    const int T = smp ? 32 : 2048;
    f32x4 a[16 + W - 1];
#pragma unroll
    for (int i = 0; i < 16; ++i) a[W - 1 + i] = *(const f32x4*)(xf + (size_t)(r0 + i) * D + c);
#pragma unroll
    for (int k = 1; k < W; ++k) { const int tt = t0 - k;
        if (tt >= 0) a[W - 1 - k] = *(const f32x4*)(xf + (size_t)(r0 - k) * D + c);
        else if (smp) a[W - 1 - k] = *(const f32x4*)(pst + ((size_t)b * 15 + (15 + tt)) * 2048 + c);
        else a[W - 1 - k] = (f32x4){0.f, 0.f, 0.f, 0.f}; }
    f32x4 s = (f32x4){0.f, 0.f, 0.f, 0.f};
#pragma unroll
    for (int k = 1; k < W; ++k) s += a[W - 1 - k];
#pragma unroll
    for (int i = 0; i < 16; ++i) {
        const int t = t0 + i; const f32x4 x = a[W - 1 + i];
        s += x;
        const int pos = smp ? 1024 + t : t; const int cnt = (pos + 1) < W ? (pos + 1) : W;
        const f32x4 dd = s * (1.0f / (float)cnt) - x;
        u32x2 w; w.x = pk2(dd[0], dd[1]); w.y = pk2(dd[2], dd[3]); *(u32x2*)(pd + (size_t)(r0 + i) * D + c) = w;
        s -= a[i];
        if (t >= T - 15) {
            float* dst = smp ? (out + O_SPOOL + (((size_t)j * 8 + b) * 15 + (t - (T - 15))) * 2048 + c) : (out + O_PPOOL + (((size_t)j * 4 + b) * 15 + (t - (T - 15))) * 2048 + c);
            *(f32x4*)dst = x;
        }
    }
}
DI void pool_phase(const Frame& F0, const Params& p, int j) {
    const Frame F = refresh(F0);
    unsigned char* ws = p.ws;
    const float* xf = (const float*)(ws + WS_XF); bf16_t* pd = (bf16_t*)(ws + WS_MIX);
    const float* pst = p.in[9] + (size_t)j * 8 * 15 * 2048;
    const int c = F.tid * 4, g2 = F.wave >> 1;
    for (int task = F.vcu; task < 528; task += F.G) {
        const int r0 = task * 16;
        if (g2 == 0) pool_seg<2>(xf, pst, pd, p.out, j, r0, c);
        else if (g2 == 1) pool_seg<4>(xf, pst, pd, p.out, j, r0, c);
        else if (g2 == 2) pool_seg<8>(xf, pst, pd, p.out, j, r0, c);
        else pool_seg<16>(xf, pst, pd, p.out, j, r0, c);
    }
}

__global__ void __launch_bounds__(512, 2) mk_fwd(Params p) {
    extern __shared__ __attribute__((aligned(16))) unsigned char lds_raw[];
    Frame F;
    F.lds = (LAS unsigned char*)lds_raw;
    F.tid = threadIdx.x; F.lane = F.tid & 63; F.wave = __builtin_amdgcn_readfirstlane(F.tid >> 6);
    F.G = gridDim.x; { const int bx = blockIdx.x; F.vcu = (F.G % 8 == 0) ? (bx % 8) * (F.G / 8) + bx / 8 : bx; }
    volatile LAS unsigned* MISC = (volatile LAS unsigned*)(F.lds + MISC_OFF);
    if (F.tid < 16) MISC[F.tid] = 0u;
    __syncthreads();
    unsigned char* ws = p.ws;
    XcdBarrier bar; bar.bar = (unsigned*)(ws + WS_CTL); bar.x = 0; bar.st = MISC;
    const bool multi = (MK_LAUNCHES == 1) || (p.ph_hi - p.ph_lo) > 1;
    if (multi) bar = xcd_barrier_post((unsigned*)(ws + WS_CTL), MISC);
    bool did = false;
#if MK_LAUNCHES == 1
    constexpr int lo = 0, hi = NPH;
#else
    const int lo = p.ph_lo, hi = p.ph_hi;
#endif
#define PHASE(id) if (lo <= (id) && (id) < hi && ((did ? (xcd_barrier(bar), (((PROBE_DUP) >> 14) & 1) ? xcd_barrier(bar) : (void)0, 0) : 0), did = true, __builtin_amdgcn_s_waitcnt(0), true))
    LAS unsigned char* stage = F.lds + STAGE_OFF;
    const int G = F.G, vcu = F.vcu;

    bf16_t* xb = (bf16_t*)(ws + WS_XB); float* xf = (float*)(ws + WS_XF); float* tb = (float*)(ws + WS_TB); float* slab = (float*)(ws + WS_SLAB);

    PHASE(0) DUP(0) { p0_prologue(F, p); }

    PHASE(1) DUP(1) {
        const bf16_t* membf = (const bf16_t*)(ws + WS_MEMBF);
        { DecMemKV dc{(unsigned)WS_MEMBF, (unsigned)WS_WK, (unsigned)WS_WV};
          EpiF32<F_MEMKV> ep{p.out, 2048, nullptr, nullptr, (bf16_t*)(ws + WS_MEMK), 2048, nullptr};
          gemm_phase(F.wave, (const char*)ws, stage, 2048, 2048, first_of(vcu, G, 0), G, 256, dc, ep); }
        { DecMemVT dc{(unsigned)WS_WV, (unsigned)WS_MEMBF};
          EpiBF<BF_PLAIN> ep{(bf16_t*)(ws + WS_MEMVT), 256, nullptr, nullptr, nullptr, nullptr, 0.f, nullptr};
          gemm_phase(F.wave, (const char*)ws, stage, 2048, 2048, first_of(vcu, G, 256), G, 128, dc, ep); }
    }

    for (int l = 0; l < 4; ++l) {
        const int j = l >> 1, base = 2 + 14 * l;
        const float* lng = p.in[32] + (size_t)l * 3 * D; const float* lnb = p.in[33] + (size_t)l * 3 * D;
        if ((l & 1) == 0) {
            PHASE(base + 0) DUP(2) {
                DecDense dc{(unsigned)WS_XB, (unsigned)(WS_WIN + (size_t)(j * INP * 2048) * 2), 2048, 2048, INP, 33, 12, 1 << 20, 0, 2048, 0, 0};
                EpiBF<BF_PLAIN> ep{(bf16_t*)(ws + WS_ZB), INP, nullptr, nullptr, nullptr, nullptr, 0.f, nullptr};
                gemm_phase(F.wave, (const char*)ws, stage, 2048, 2048, first_of(vcu, G, 0), G, 33 * 12, dc, ep);
            }
            PHASE(base + 1) DUP(3) { e2_phase(F, p, j); }
            PHASE(base + 2) DUP(4) {
                int off = 0;
                {
                    DecDense dc{(unsigned)WS_UCB, (unsigned)(WS_WGT + (size_t)(j * 2048 * 256) * 2), 1024, 256, 2048, 33, 8, 2, 256, 256, 0, 0};
                    EpiBF<BF_SIGMOID> ep{(bf16_t*)(ws + WS_GAT), 2048, (const float*)(ws + WS_CTL + 32768) + (size_t)j * 2048, nullptr, nullptr, nullptr, 0.f, nullptr};
                    gemm_phase(F.wave, (const char*)ws, stage, 1024, 256, first_of(vcu, G, off), G, 33 * 8, dc, ep); off += 33 * 8;
                }
                {
                    DecDense dc{(unsigned)WS_CQN, (unsigned)(WS_WUQ + (size_t)(j * 1536 * 512) * 2), 512, 512, 1536, 33, 6, 1 << 20, 0, 512, 0, 0};
                    EpiBF<BF_ROPE> ep{(bf16_t*)(ws + WS_Q), 1536, nullptr, (const float*)(ws + WS_ROPE), (const float*)(ws + WS_ROPE) + 2048 * 32, nullptr, 0.f, nullptr};
                    gemm_phase(F.wave, (const char*)ws, stage, 512, 512, first_of(vcu, G, off), G, 33 * 6, dc, ep); off += 33 * 6;
                }
                {
                    DecDense dc{(unsigned)(WS_CKV + (size_t)(j * KEYSPAD * 256) * 2), (unsigned)(WS_WUK + (size_t)(j * 1024 * 256) * 2), 256, 256, 1024, 65, 4, 1 << 20, 0, 256, 0, 0};
                    EpiBF<BF_PLAIN> ep{(bf16_t*)(ws + WS_KN), 1024, nullptr, nullptr, nullptr, nullptr, 0.f, nullptr};
                    gemm_phase(F.wave, (const char*)ws, stage, 256, 256, first_of(vcu, G, off), G, 65 * 4, dc, ep); off += 65 * 4;
                }
                {
                    DecDense dc{(unsigned)(WS_WUV + (size_t)(j * 1024 * 256) * 2), (unsigned)(WS_CKV + (size_t)(j * KEYSPAD * 256) * 2), 256, 256, KEYS, 4, 65, 1 << 20, 0, 256, 0, 0};
                    EpiBF<BF_PLAIN> ep{(bf16_t*)(ws + WS_VT), KEYS, nullptr, nullptr, nullptr, nullptr, 0.f, nullptr};
                    gemm_phase(F.wave, (const char*)ws, stage, 256, 256, first_of(vcu, G, off), G, 4 * 65, dc, ep); off += 4 * 65;
                }
            }
            PHASE(base + 3) { DUP(5) { scan_phase(F, p, j); __syncthreads(); } DUP(6) { attn_phase(F, p, j); } }
            PHASE(base + 4) DUP(7) {
                DecDense dc{(unsigned)WS_MIX, (unsigned)(WS_WOUT + (size_t)(j * 2048 * 2048) * 2), 2048, 2048, 2048, 32, 8, 1 << 20, 0, 2048, 16, 128};
                EpiF32<F_RESID> ep{tb, 2048, xf, nullptr, nullptr, 0, slab};
                gemm_phase(F.wave, (const char*)ws, stage, 2048, 2048, first_of(vcu, G, 0), G, 32 * 8 + 8 * 16, dc, ep);
            }
            PHASE(base + 5) DUP(8) { ln_phase(F, tb, lng, lnb, xf, xb, slab, 16, rep_ == 0); }
        } else {
            PHASE(base + 0) DUP(9) { pool_phase(F, p, j); }
            PHASE(base + 1) DUP(9) {
                DecDense dc{(unsigned)WS_MIX, (unsigned)(WS_WPOOL + (size_t)(j * 2048 * 512) * 2), 2048, 512, 2048, 32, 8, 2, 512, 512, 4, 128};
                EpiF32<F_RESID> ep{tb, 2048, xf, p.in[25] + (size_t)j * 2048, nullptr, 0, slab};
                gemm_phase(F.wave, (const char*)ws, stage, 2048, 512, first_of(vcu, G, 0), G, 32 * 8 + 8 * 4, dc, ep);
            }
            PHASE(base + 2) DUP(8) { ln_phase(F, tb, lng, lnb, xf, xb, slab, 4, rep_ == 0); }
        }
        PHASE(base + 6) DUP(10) {
            DecDense dc{(unsigned)WS_XB, (unsigned)(WS_WQ + (size_t)(l * 2048 * 2048) * 2), 2048, 2048, 2048, 33, 8, 1 << 20, 0, 2048, 0, 0};
            EpiBF<BF_PLAIN> ep{(bf16_t*)(ws + WS_QX), 2048, nullptr, nullptr, nullptr, nullptr, 0.f, nullptr};
            gemm_phase(F.wave, (const char*)ws, stage, 2048, 2048, first_of(vcu, G, 0), G, 33 * 8, dc, ep);
            if (l < 3) { const int rem = 33 * 8 - G;
                const bool tail = rem > 0 && rem < G; const Frame Ff = refresh(F);
                tr_range(Ff, p, g_trtab.lstart[l + 1], g_trtab.lstart[l + 1] + 1240, tail ? vcu - rem : vcu, tail ? G - rem : G); }
        }
        PHASE(base + 7) DUP(11) {
            DecXS dc{(unsigned)WS_QX, (unsigned)(WS_MEMK + (size_t)(l * 12 * 256 * 2048) * 2)};
            EpiBF<BF_EXP> ep{(bf16_t*)(ws + WS_E), 1024, nullptr, nullptr, nullptr, (float*)(ws + WS_RS4), 0.044194173824159216f, nullptr};
            gemm_phase(F.wave, (const char*)ws, stage, 2048, 2048, first_of(vcu, G, 0), G, 160, dc, ep);
        }
        PHASE(base + 8) DUP(11) {
            DecXPV dc{(unsigned)WS_E, (unsigned)(WS_MEMVT + (size_t)(l * 12 * 2048 * 256) * 2)};
            EpiBF<BF_DIV> ep{(bf16_t*)(ws + WS_OX), 2048, nullptr, nullptr, nullptr, (float*)(ws + WS_RS4), 0.f, nullptr};
            gemm_phase(F.wave, (const char*)ws, stage, 1024, 256, first_of(vcu, G, 0), G, 320, dc, ep);
        }
        PHASE(base + 9) DUP(7) {
            DecDense dc{(unsigned)WS_OX, (unsigned)(WS_WO + (size_t)(l * 2048 * 2048) * 2), 2048, 2048, 2048, 32, 8, 1 << 20, 0, 2048, 16, 128};
            EpiF32<F_RESID> ep{tb, 2048, xf, nullptr, nullptr, 0, slab};
            gemm_phase(F.wave, (const char*)ws, stage, 2048, 2048, first_of(vcu, G, 0), G, 32 * 8 + 8 * 16, dc, ep);
        }
        PHASE(base + 10) DUP(8) { ln_phase(F, tb, lng + D, lnb + D, xf, xb, slab, 16, rep_ == 0); }
        PHASE(base + 11) DUP(12) {
            DecDense dc{(unsigned)WS_XB, (unsigned)(WS_WUP + (size_t)(l * 8192 * 2048) * 2), 2048, 2048, DFF, 33, 32, 1 << 20, 0, 2048, 0, 0};
            EpiBF<BF_RELU2> ep{(bf16_t*)(ws + WS_HB), DFF, nullptr, nullptr, nullptr, nullptr, 0.f, nullptr};
            gemm_phase(F.wave, (const char*)ws, stage, 2048, 2048, first_of(vcu, G, 0), G, 33 * 32, dc, ep);
            if (l < 3) { const int rem = (33 * 32) % G;
                const bool tail = rem > 0; const Frame Ff = refresh(F);
                tr_range(Ff, p, g_trtab.lstart[l + 1] + 1240, g_trtab.lstart[l + 2], tail ? vcu - rem : vcu, tail ? G - rem : G); }
        }
        PHASE(base + 12) DUP(13) {
            DecDense dc{(unsigned)WS_HB, (unsigned)(WS_WDN + (size_t)(l * 2048 * 8192) * 2), DFF, DFF, 2048, 32, 8, 1 << 20, 0, DFF, 32, 256};
            EpiF32<F_RESID> ep{tb, 2048, xf, nullptr, nullptr, 0, slab};
            gemm_phase(F.wave, (const char*)ws, stage, DFF, DFF, first_of(vcu, G, 0), G, 32 * 8 + 8 * 32, dc, ep);
        }
        PHASE(base + 13) DUP(8) { ln_phase(F, tb, lng + 2 * D, lnb + 2 * D, (l == 3) ? (p.out + O_Y) : xf, xb, slab, 32, rep_ == 0); }
    }
#undef PHASE
}

extern "C" void kernel_launch(void* const* d_in, const int* in_sizes, int n_in, void* d_out, int out_size, void* d_ws, size_t ws_size, hipStream_t stream) {
    static int grid = 0;
    if (grid == 0) {
        if (n_in != 34 || (size_t)out_size != O_END || ws_size < WS_END) {
            fprintf(stderr, "kernel_launch: expected 34 inputs, %zu outputs, >= %zu bytes of workspace; got %d, %d, %zu; nothing launched\n", (size_t)O_END, (size_t)WS_END, n_in, out_size, ws_size);
            grid = -1; return; }
        int dev = 0, cus = 0, per_cu = 0;
        if (hipGetDevice(&dev) != hipSuccess || hipDeviceGetAttribute(&cus, hipDeviceAttributeMultiprocessorCount, dev) != hipSuccess) { grid = -1; return; }
        if (hipFuncSetAttribute((const void*)mk_fwd, hipFuncAttributeMaxDynamicSharedMemorySize, LDS_BYTES) != hipSuccess) { fprintf(stderr, "kernel_launch: hipFuncSetAttribute failed\n"); grid = -1; return; }
        if (hipOccupancyMaxActiveBlocksPerMultiprocessor(&per_cu, (const void*)mk_fwd, 512, LDS_BYTES) != hipSuccess || per_cu < 1) {
            fprintf(stderr, "kernel_launch: occupancy query reports %d workgroups per CU\n", per_cu); }
        (void)hipGetLastError();
        grid = cus;
    }
    if (grid < 0) return;
    if (hipMemsetAsync((char*)d_ws + WS_CTL, 0, 32768, stream) != hipSuccess) { fprintf(stderr, "kernel_launch: memset failed\n"); return; }
    Params p{};
    for (int i = 0; i < 34; ++i) p.in[i] = (const float*)d_in[i];
    p.out = (float*)d_out; p.ws = (unsigned char*)d_ws;
#if MK_LAUNCHES == 1
    p.ph_lo = 0; p.ph_hi = NPH;
    hipLaunchKernelGGL(mk_fwd, dim3(grid), dim3(512), LDS_BYTES, stream, p);
#else
    for (int ph = 0; ph < NPH; ++ph) { p.ph_lo = ph; p.ph_hi = ph + 1; hipLaunchKernelGGL(mk_fwd, dim3(grid), dim3(512), LDS_BYTES, stream, p); }
#endif
    const hipError_t le = hipPeekAtLastError();
    if (le != hipSuccess) fprintf(stderr, "kernel_launch: launch failed: %s\n", hipGetErrorName(le));
}
```
